# Optimizing an MI355X kernel written in HIP

```python
import jax, jax.numpy as jnp
from jax import lax
import numpy as np

D_MODEL = 1024
BATCH = 32
SEQ = 256
DEPTH = 4
DEC_BATCH = 2
DEC_SEQ = 2048
PAST_LEN = 256

GRID_W = 64
N_EVEN = (DEPTH + 1) // 2
N_ODD = DEPTH // 2
N_MOD = 6
D_FF = ((8 * D_MODEL // 3 + 255) // 256) * 256
DA = D_MODEL // 2
HD_A = 64
H_A = DA // HD_A
W_LORA = 64
A_LORA = 64
G_LORA = 128
H_B = 4
NOPE = 128
ROPE_DIM = 64
V_DIM = DA // H_B
Q_LORA = 384
KV_LORA = 256
ATTN_SCALE = (NOPE + ROPE_DIM) ** -0.5
ROPE_AXIS_FREQS = ROPE_DIM // 4
ROPE_BASE = 10000.0
Q_BLOCK = 128
RWKV_IN = 3 * DA + W_LORA + A_LORA + G_LORA
MLA_IN = Q_LORA + KV_LORA + ROPE_DIM
IN_DIM = RWKV_IN + MLA_IN
POOL_WINDOWS = (2, 4, 8, 16)
N_POOL = len(POOL_WINDOWS)
GP = D_MODEL // N_POOL
EPS = 1e-6
GN_EPS = 64e-5

kernel_name = 'hybrid_rwkv7_mla_pool_diffusion_step'


def rms_norm(x, g):
    x32 = x.astype(jnp.float32)
    y = x32 * lax.rsqrt(jnp.mean(x32 * x32, axis=-1, keepdims=True) + EPS)
    return (y * g.astype(jnp.float32)).astype(x.dtype)


def adaln(cond, w, b):
    mod = jax.nn.silu(cond) @ w + b
    mod = mod.reshape((-1, 1, N_MOD, D_MODEL))
    return tuple(mod[:, :, i] for i in range(N_MOD))


def modulate(x, shift, scale):
    return x * (1 + scale) + shift


def swiglu(h, w1, w3, w2):
    return (jax.nn.silu(h @ w1) * (h @ w3)) @ w2


def centred_shift(h, mu):
    zeros = jnp.zeros_like(h[:, :1])
    prev = jnp.concatenate([zeros, h[:, :-1]], axis=1)
    nxt = jnp.concatenate([h[:, 1:], zeros], axis=1)
    return h + mu * (0.5 * (prev + nxt) - h)


def rot_half(x, ang):
    half = x.shape[-1] // 2
    x1, x2 = x[..., :half], x[..., half:]
    cos, sin = jnp.cos(ang), jnp.sin(ang)
    return jnp.concatenate([x1 * cos - x2 * sin, x2 * cos + x1 * sin], axis=-1)


def rope_axial(x, ang_row, ang_col):
    half = ROPE_DIM // 2
    return jnp.concatenate([rot_half(x[..., :half], ang_row), rot_half(x[..., half:], ang_col)], axis=-1)


def wkv_scan(r, k, v, w, kk, a, s0, reverse):
    xs = tuple(jnp.moveaxis(z, 1, 0) for z in (r, k, v, w, kk, a))

    def step(s, inp):
        r_t, k_t, v_t, w_t, kk_t, a_t = inp
        s_kk = jnp.einsum('bhvk,bhk->bhv', s, kk_t)
        s = (s * w_t[:, :, None, :] - s_kk[..., None] * (kk_t * a_t)[:, :, None, :]
             + v_t[..., None] * k_t[:, :, None, :])
        return s, jnp.einsum('bhvk,bhk->bhv', s, r_t)

    s_fin, ys = lax.scan(step, s0, xs, reverse=reverse)
    return jnp.moveaxis(ys, 0, 1), s_fin


def rwkv_mix(rw, s0, p):
    B, T, _ = rw.shape
    rw = rw.astype(jnp.float32)
    r, k, v, wd, ad, gd = jnp.split(
        rw, [DA, 2 * DA, 3 * DA, 3 * DA + W_LORA, 3 * DA + W_LORA + A_LORA], axis=-1)
    heads = lambda z: z.reshape(B, T, H_A, HD_A)
    g = jax.nn.sigmoid(gd) @ p['g_up']
    kk = heads(k * p['k_k'])
    kk = kk / (jnp.sqrt(jnp.sum(kk * kk, axis=-1, keepdims=True)) + 1e-12)
    rh, vh = heads(r), heads(v)
    ys, states = [], []
    for d in range(2):
        w_log = -jax.nn.softplus(-(p['w0'][d] + jnp.tanh(wd) @ p['w_up'][d])) - 0.5
        w = jnp.exp(-jnp.exp(w_log))
        a = jax.nn.sigmoid(p['a0'][d] + ad @ p['a_up'][d])
        k_d = k * (1 + (a - 1) * p['k_a'])
        y, s = wkv_scan(rh, heads(k_d), vh, heads(w), kk, heads(a),
                        s0[:, d].astype(jnp.float32), reverse=(d == 1))
        ys.append(y)
        states.append(s)
    y = ys[0] + ys[1]
    mu = jnp.mean(y, axis=-1, keepdims=True)
    var = jnp.mean(jnp.square(y - mu), axis=-1, keepdims=True)
    yn = ((y - mu) * lax.rsqrt(var + GN_EPS)).reshape(B, T, DA) * p['ln_g'] + p['ln_b']
    bonus = jnp.sum(rh * heads(k) * p['r_k'], axis=-1, keepdims=True) * vh
    out = (yn + bonus.reshape(B, T, DA)) * g
    return out, jnp.stack(states, axis=1)


def mla_project(hm, p):
    B, T, _ = hm.shape
    c_q, c_kv, k_r = jnp.split(hm, [Q_LORA, Q_LORA + KV_LORA], axis=-1)
    q = (rms_norm(c_q, p['cq_g']) @ p['uq_w']).reshape(B, T, H_B, NOPE + ROPE_DIM)
    q_n = rms_norm(q[..., :NOPE], p['qn_g'])
    q_r = rms_norm(q[..., NOPE:], p['qr_g'])
    return q_n, q_r, rms_norm(c_kv, p['ckv_g']), rms_norm(k_r, p['kr_g'])


def mla_expand(c_kv, p):
    B, T, _ = c_kv.shape
    kv = (c_kv @ p['ukv_w']).reshape(B, T, H_B, NOPE + V_DIM)
    return rms_norm(kv[..., :NOPE], p['kn_g']), kv[..., NOPE:]


def mla_attend(q_n, q_r, k_n, k_r, v):
    s = jnp.einsum('bqhd,bkhd->bhqk', q_n, k_n) + jnp.einsum('bqhd,bkd->bhqk', q_r, k_r)
    pr = jax.nn.softmax(s.astype(jnp.float32) * ATTN_SCALE, axis=-1).astype(v.dtype)
    return jnp.einsum('bhqk,bkhd->bqhd', pr, v)


def mla_attend_blocks(q_n, q_r, k_n, k_r, v):
    B, T = q_n.shape[:2]
    nb = T // Q_BLOCK
    qn_b = q_n.reshape(B, nb, Q_BLOCK, H_B, NOPE).swapaxes(0, 1)
    qr_b = q_r.reshape(B, nb, Q_BLOCK, H_B, ROPE_DIM).swapaxes(0, 1)
    o = lax.map(lambda qs: mla_attend(qs[0], qs[1], k_n, k_r, v), (qn_b, qr_b))
    return o.swapaxes(0, 1).reshape(B, T, H_B * V_DIM)


def even_mixer_context(h, p):
    B, C, _ = h.shape
    proj = h @ p['in_w']
    rw = centred_shift(proj[..., :RWKV_IN], p['shift_mu'])
    s0 = jnp.zeros((B, 2, H_A, HD_A, HD_A), jnp.float32)
    a_out, s_fin = rwkv_mix(rw, s0, p)
    q_n, q_r, c_kv, k_r = mla_project(proj[..., RWKV_IN:], p)
    k_n, v = mla_expand(c_kv, p)
    b_out = mla_attend(q_n, q_r, k_n, k_r, v).reshape(B, C, DA)
    out = jnp.concatenate([a_out.astype(b_out.dtype), b_out], axis=-1) @ p['out_w']
    return out, s_fin, c_kv, k_r


def even_mixer_latent(h, s_ctx, ckv_ctx, kr_ctx, ang_row, ang_col, p):
    proj = h @ p['in_w']
    rw = centred_shift(proj[..., :RWKV_IN], p['shift_mu'])
    a_out, _ = rwkv_mix(rw, s_ctx, p)
    q_n, q_r, c_kv, k_r = mla_project(proj[..., RWKV_IN:], p)
    q_r = rope_axial(q_r, ang_row[:, None], ang_col[:, None])
    k_r = rope_axial(k_r, ang_row, ang_col)
    k_n, v = mla_expand(c_kv, p)
    kn_c, v_c = mla_expand(ckv_ctx, p)
    k_n_all = jnp.concatenate([k_n, kn_c.astype(k_n.dtype)], axis=1)
    k_r_all = jnp.concatenate([k_r, kr_ctx.astype(k_r.dtype)], axis=1)
    v_all = jnp.concatenate([v, v_c.astype(v.dtype)], axis=1)
    b_out = mla_attend_blocks(q_n, q_r, k_n_all, k_r_all, v_all)
    return jnp.concatenate([a_out.astype(b_out.dtype), b_out], axis=-1) @ p['out_w']


def pool_mixer(h, pool_w, pool_scale):
    B, T, _ = h.shape
    h32 = h.astype(jnp.float32)
    cs = jnp.concatenate([jnp.zeros((B, 1, D_MODEL), jnp.float32), jnp.cumsum(h32, axis=1)], axis=1)
    t = jnp.arange(T)
    diffs = []
    for gi, win in enumerate(POOL_WINDOWS):
        lo = jnp.clip(t - win // 2, 0, T)
        hi = jnp.clip(t + win // 2, 0, T)
        cg = cs[..., gi * GP:(gi + 1) * GP]
        mean = (cg[:, hi] - cg[:, lo]) / (hi - lo).astype(jnp.float32)[:, None]
        diffs.append(mean - h32[..., gi * GP:(gi + 1) * GP])
    d = jnp.stack(diffs, axis=2)
    out = jnp.einsum('btgi,gio->btgo', d, pool_w).reshape(B, T, D_MODEL)
    return (out * pool_scale).astype(h.dtype)


def setup_inputs(seed: int = 0) -> dict:
    key = jax.random.key(seed)
    kit = iter(list(jax.random.split(key, 40)))
    f32 = jnp.float32

    def nrm(shape, scale):
        return scale * jax.random.normal(next(kit), shape, f32)

    def gain(shape, s=0.01):
        return 1.0 + nrm(shape, s)

    return {
        'x_prompt': nrm((BATCH, SEQ, D_MODEL), 1.0),
        'x_sample': nrm((DEC_BATCH, DEC_SEQ, D_MODEL), 1.0),
        'c': nrm((DEC_BATCH, D_MODEL), 1.0),
        'state_rwkv': nrm((DEC_BATCH, N_EVEN, 2, H_A, HD_A, HD_A), 0.5),
        'cache_mla_ckv': nrm((DEC_BATCH, N_EVEN, PAST_LEN, KV_LORA), 1.0),
        'cache_mla_krope': nrm((DEC_BATCH, N_EVEN, PAST_LEN, ROPE_DIM), 1.0),
        'c_ctx': nrm((D_MODEL,), 1.0),
        'norm1_g': gain((DEPTH, D_MODEL)),
        'norm2_g': gain((DEPTH, D_MODEL)),
        'ada_w': nrm((DEPTH, D_MODEL, N_MOD * D_MODEL), D_MODEL ** -0.5),
        'ada_b': nrm((DEPTH, N_MOD * D_MODEL), 0.01),
        'ffn_w1': nrm((DEPTH, D_MODEL, D_FF), D_MODEL ** -0.5),
        'ffn_w3': nrm((DEPTH, D_MODEL, D_FF), D_MODEL ** -0.5),
        'ffn_w2': nrm((DEPTH, D_FF, D_MODEL), D_FF ** -0.5),
        'in_w': nrm((N_EVEN, D_MODEL, IN_DIM), D_MODEL ** -0.5),
        'out_w': nrm((N_EVEN, D_MODEL, D_MODEL), D_MODEL ** -0.5),
        'shift_mu': jax.random.uniform(next(kit), (N_EVEN, RWKV_IN), f32),
        'rwkv_w0': jax.random.uniform(next(kit), (N_EVEN, 2, DA), f32, -4.0, 1.0),
        'rwkv_w_up': nrm((N_EVEN, 2, W_LORA, DA), 0.1),
        'rwkv_a0': nrm((N_EVEN, 2, DA), 0.1),
        'rwkv_a_up': nrm((N_EVEN, 2, A_LORA, DA), 0.1),
        'rwkv_g_up': nrm((N_EVEN, G_LORA, DA), G_LORA ** -0.5),
        'rwkv_k_k': gain((N_EVEN, DA), 0.1),
        'rwkv_k_a': gain((N_EVEN, DA), 0.1),
        'rwkv_r_k': nrm((N_EVEN, H_A, HD_A), 0.1),
        'rwkv_ln_g': gain((N_EVEN, DA)),
        'rwkv_ln_b': nrm((N_EVEN, DA), 0.01),
        'mla_cq_g': gain((N_EVEN, Q_LORA)),
        'mla_uq_w': nrm((N_EVEN, Q_LORA, H_B * (NOPE + ROPE_DIM)), Q_LORA ** -0.5),
        'mla_ckv_g': gain((N_EVEN, KV_LORA)),
        'mla_ukv_w': nrm((N_EVEN, KV_LORA, H_B * (NOPE + V_DIM)), KV_LORA ** -0.5),
        'mla_qn_g': gain((N_EVEN, NOPE)),
        'mla_qr_g': gain((N_EVEN, ROPE_DIM)),
        'mla_kn_g': gain((N_EVEN, NOPE)),
        'mla_kr_g': gain((N_EVEN, ROPE_DIM)),
        'pool_w': nrm((N_ODD, N_POOL, GP, GP), GP ** -0.5),
        'pool_scale': gain((N_ODD, D_MODEL), 0.1),
    }


def reference(x_prompt, x_sample, c, state_rwkv, cache_mla_ckv, cache_mla_krope, c_ctx,
              norm1_g, norm2_g, ada_w, ada_b, ffn_w1, ffn_w3, ffn_w2,
              in_w, out_w, shift_mu, rwkv_w0, rwkv_w_up, rwkv_a0, rwkv_a_up, rwkv_g_up,
              rwkv_k_k, rwkv_k_a, rwkv_r_k, rwkv_ln_g, rwkv_ln_b,
              mla_cq_g, mla_uq_w, mla_ckv_g, mla_ukv_w, mla_qn_g, mla_qr_g, mla_kn_g, mla_kr_g,
              pool_w, pool_scale):
    S = x_sample.shape[1]
    n_rows = S // GRID_W
    row = jnp.repeat(jnp.arange(n_rows), GRID_W).astype(jnp.float32)
    col = jnp.tile(jnp.arange(GRID_W), n_rows).astype(jnp.float32)
    freqs = ROPE_BASE ** (-jnp.arange(ROPE_AXIS_FREQS, dtype=jnp.float32) / ROPE_AXIS_FREQS)
    ang_row = row[:, None] * freqs
    ang_col = col[:, None] * freqs

    y_p, y_s = x_prompt, x_sample
    new_s, new_ckv, new_kr = [], [], []
    for l in range(DEPTH):
        sh1, sc1, g1, sh2, sc2, g2 = adaln(c_ctx, ada_w[l], ada_b[l])
        ls1, lc1, lg1, ls2, lc2, lg2 = adaln(c, ada_w[l], ada_b[l])
        hp = modulate(rms_norm(y_p, norm1_g[l]), sh1, sc1)
        hs = modulate(rms_norm(y_s, norm1_g[l]), ls1, lc1)
        if l % 2 == 0:
            i = l // 2
            p = dict(in_w=in_w[i], out_w=out_w[i], shift_mu=shift_mu[i],
                     w0=rwkv_w0[i], w_up=rwkv_w_up[i], a0=rwkv_a0[i], a_up=rwkv_a_up[i],
                     g_up=rwkv_g_up[i], k_k=rwkv_k_k[i], k_a=rwkv_k_a[i], r_k=rwkv_r_k[i],
                     ln_g=rwkv_ln_g[i], ln_b=rwkv_ln_b[i],
                     cq_g=mla_cq_g[i], uq_w=mla_uq_w[i], ckv_g=mla_ckv_g[i], ukv_w=mla_ukv_w[i],
                     qn_g=mla_qn_g[i], qr_g=mla_qr_g[i], kn_g=mla_kn_g[i], kr_g=mla_kr_g[i])
            mp, s_fin, ckv, kr = even_mixer_context(hp, p)
            ms = even_mixer_latent(hs, state_rwkv[:, i], cache_mla_ckv[:, i], cache_mla_krope[:, i],
                                   ang_row, ang_col, p)
            new_s.append(s_fin.astype(x_prompt.dtype))
            new_ckv.append(ckv)
            new_kr.append(kr)
        else:
            j = l // 2
            mp = pool_mixer(hp, pool_w[j], pool_scale[j])
            ms = pool_mixer(hs, pool_w[j], pool_scale[j])
        y_p = y_p + g1 * mp
        y_s = y_s + lg1 * ms
        y_p = y_p + g2 * swiglu(modulate(rms_norm(y_p, norm2_g[l]), sh2, sc2),
                                ffn_w1[l], ffn_w3[l], ffn_w2[l])
        y_s = y_s + lg2 * swiglu(modulate(rms_norm(y_s, norm2_g[l]), ls2, lc2),
                                 ffn_w1[l], ffn_w3[l], ffn_w2[l])

    new_state_rwkv = jnp.stack(new_s, axis=1)
    new_cache_mla_ckv = jnp.stack(new_ckv, axis=1)
    new_cache_mla_krope = jnp.stack(new_kr, axis=1)
    return (y_p, y_s, new_state_rwkv, new_cache_mla_ckv, new_cache_mla_krope)
```

```cpp
#include <hip/hip_runtime.h>
#include <hip/hip_bf16.h>
#include <cstdio>
#include <cstdint>
#include <cmath>

#define DI __device__ __forceinline__
#define LAS __attribute__((address_space(3)))
#define GAS __attribute__((address_space(1)))

constexpr int D = 1024, NT = 12288, NCTX = 8192, TCTX = 256, TLAT = 2048, NKV = 12800;
constexpr int DFF = 2816, IN_DIM = 2496, IN_PAD = 2560, DA = 512;
constexpr int OUT_Y = 0, OUT_STATE = 12582912, OUT_CKV = 16777216, OUT_KR = 20971520, OUT_TOTAL = 22020096;
constexpr float EPS = 1e-6f, GN_EPS = 64e-5f;
constexpr float QSCALE = 0.07216878364870322f * 1.4426950408889634f;

enum { I_XP = 0, I_XS, I_C, I_STATE, I_CCKV, I_CKR, I_CCTX, I_N1G, I_N2G, I_ADAW, I_ADAB, I_W1, I_W3, I_W2, I_INW, I_OUTW, I_MU, I_W0, I_WUP, I_A0, I_AUP, I_GUP,
       I_KK, I_KA, I_RK, I_LNG, I_LNB, I_CQG, I_UQW, I_CKVG, I_UKVW, I_QNG, I_QRG, I_KNG, I_KRG, I_POOLW, I_POOLS, N_IN };

constexpr size_t MiB = 1u << 20;
constexpr size_t WS_CTL = 0, CTL_ZERO_BYTES = 64 * 1024;
constexpr size_t WS_MOD = 1 * MiB;
constexpr size_t WS_RS = WS_MOD + 512 * 1024;
constexpr size_t WS_WINT = 2 * MiB;
constexpr size_t WS_WOUTT = WS_WINT + (size_t)2 * 2560 * 1024 * 2;
constexpr size_t WS_W13T = WS_WOUTT + (size_t)2 * 1024 * 1024 * 2;
constexpr size_t WS_W2T = WS_W13T + (size_t)4 * 5632 * 1024 * 2;
constexpr size_t WS_WUQT = WS_W2T + (size_t)4 * 1024 * 2816 * 2;
constexpr size_t WS_WUKVT = WS_WUQT + (size_t)2 * 768 * 384 * 2;
constexpr size_t WS_POOLT = WS_WUKVT + (size_t)2 * 1024 * 256 * 2;
constexpr size_t WS_WLORAT = WS_POOLT + (size_t)2 * 1024 * 256 * 2;
constexpr size_t WS_XN = WS_WLORAT + (size_t)2 * 2560 * 256 * 2;
constexpr size_t WS_BIG = WS_XN + (size_t)NT * 1024 * 2;
constexpr size_t WS_RB = WS_BIG + (size_t)NT * 2816 * 2;
constexpr size_t WS_KB = WS_RB + (size_t)NT * 512 * 2;
constexpr size_t WS_VB = WS_KB + (size_t)NT * 512 * 2;
constexpr size_t WS_KKB = WS_VB + (size_t)NT * 512 * 2;
constexpr size_t WS_L = WS_KKB + (size_t)NT * 512 * 2;
constexpr size_t WS_CQ = WS_L + (size_t)NT * 256 * 2;
constexpr size_t WS_CKV = WS_CQ + (size_t)NT * 384 * 2;
constexpr size_t WS_KRB = WS_CKV + (size_t)NKV * 256 * 2;
constexpr size_t WS_QRAW = WS_KRB + (size_t)NKV * 64 * 2;
constexpr size_t WS_KVRAW = WS_QRAW + (size_t)NT * 768 * 2;
constexpr size_t WS_QF = WS_KVRAW + (size_t)NKV * 1024 * 2;
constexpr size_t WS_KF = WS_QF + (size_t)NT * 768 * 2;
constexpr size_t WS_Y0 = WS_KF + (size_t)NKV * 512 * 2;
constexpr size_t WS_END = WS_Y0 + (size_t)2 * NT * 512 * 4;
static_assert(WS_WINT % 256 == 0 && WS_XN % 256 == 0 && WS_BIG % 256 == 0 && WS_Y0 % 256 == 0, "alignment");

constexpr int RING_BYTES = 131072, LDSCTL_OFF = RING_BYTES, MISC_OFF = LDSCTL_OFF + 320, LDS_BYTES = 147456;
constexpr int NWAVES = 8, NTHR = 512;

typedef unsigned short bf16_t;
typedef float f32x4 __attribute__((ext_vector_type(4)));
typedef float f32x16 __attribute__((ext_vector_type(16)));
typedef short bf16x8 __attribute__((ext_vector_type(8)));
typedef unsigned u32x4 __attribute__((ext_vector_type(4)));
typedef unsigned u32x2 __attribute__((ext_vector_type(2)));

DI float bf2f(unsigned b) { return __uint_as_float(b << 16); }
DI unsigned pk2(float lo, float hi) { typedef float f2 __attribute__((ext_vector_type(2))); typedef __bf16 b2 __attribute__((ext_vector_type(2))); f2 v = {lo, hi}; b2 b = __builtin_convertvector(v, b2); return __builtin_bit_cast(unsigned, b); }
DI void unpack8(const u32x4 v, float* f) { f[0] = bf2f(v.x & 0xffffu); f[1] = __uint_as_float(v.x & 0xffff0000u); f[2] = bf2f(v.y & 0xffffu); f[3] = __uint_as_float(v.y & 0xffff0000u);
                                           f[4] = bf2f(v.z & 0xffffu); f[5] = __uint_as_float(v.z & 0xffff0000u); f[6] = bf2f(v.w & 0xffffu); f[7] = __uint_as_float(v.w & 0xffff0000u); }
DI u32x4 pack8(const float* f) { u32x4 o; o.x = pk2(f[0], f[1]); o.y = pk2(f[2], f[3]); o.z = pk2(f[4], f[5]); o.w = pk2(f[6], f[7]); return o; }
DI float sigm(float x) { return 1.f / (1.f + __expf(-x)); }
DI float siluf(float x) { return x / (1.f + __expf(-x)); }
DI float wave_sum(float v) {
#pragma unroll
    for (int o = 1; o < 64; o <<= 1) v += __shfl_xor(v, o);
    return v;
}
DI int mod_set(int row) { return row < NCTX ? 0 : 1 + ((row - NCTX) >> 11); }
#define ONE_LAUNCH 1
namespace pg8 {
#define PG8_LAS __attribute__((address_space(3)))
typedef unsigned short bf16_t;
typedef short bf16x8 __attribute__((ext_vector_type(8)));
typedef float f32x4 __attribute__((ext_vector_type(4)));
typedef unsigned u32x4 __attribute__((ext_vector_type(4)));
constexpr int BM = 256, BK = 64, HALF = 128, HTB = HALF * BK * 2  , STAGE_BYTES = 8 * HTB, NXCD = 8, WGM = 8;

__host__ __device__ __forceinline__ int lds_byte(int r, int c) { const int st = (r >> 4) * 2 + (c >> 5), rr = r & 15, cc = c & 31, ob = rr * 64 + cc * 2; return st * 1024 + (ob ^ (((ob >> 9) & 1) << 5)); }
__host__ __device__ __forceinline__ void stage_rc(int b, int& R, int& C) { const int st = b / 1024, sb = b % 1024, swz = sb ^ (((sb >> 9) & 1) << 5); R = (st >> 1) * 16 + swz / 64; C = (st & 1) * 32 + (swz % 64) / 2; }
__host__ __device__ __forceinline__ int perm32(int rho) { const int n = rho >> 4, i = rho & 15; return 8 * (i >> 2) + 4 * n + (i & 3); }

struct Unit { int pm, pn; };
struct Gemm { const bf16_t* A; const bf16_t* Bt; int M, N, K, lda, a_pn_off; };

struct StaticOrder {
    int nM, nN, nwg, G, c;
    __host__ __device__ void init(int M, int N, int G_, int c_) { nM = M / BM; nN = N / BM; nwg = nM * nN; G = G_; c = c_; }
    __host__ __device__ bool next(int i, Unit& u) const {
        const long L = (long)i * G + c; if (L >= nwg) return false;
        int wgid = (int)L; { const int q = nwg / NXCD, r = nwg % NXCD, xcd = wgid % NXCD, off = wgid / NXCD; wgid = (xcd < r ? xcd * (q + 1) : r * (q + 1) + (xcd - r) * q) + off; }
        const int nig = WGM * nN, gid = wgid / nig, fm = gid * WGM, gsz = (nM - fm) < WGM ? (nM - fm) : WGM;
        u.pm = fm + ((wgid % nig) % gsz); u.pn = (wgid % nig) / gsz; return true;
    }
    __device__ __forceinline__ void a_ready(const Unit&) const {}
    __device__ __forceinline__ void done(const Unit&) const {}
};


__device__ __forceinline__ unsigned cvt_pk_bf16(float lo, float hi) { typedef float f2 __attribute__((ext_vector_type(2))); typedef __bf16 b2 __attribute__((ext_vector_type(2))); f2 v = {lo, hi}; b2 b = __builtin_convertvector(v, b2); return __builtin_bit_cast(unsigned, b); }
__device__ __forceinline__ float sigm_(float x) { return 1.f / (1.f + __expf(-x)); }

struct EpiBf16 {
    static constexpr bool PERM = true, AFTER_DRAIN = false;
    bf16_t* O; int ldc; int lora; const float* w0; const float* a0;
    __device__ __forceinline__ void operator()(const f32x4 (&acc)[2][2][4][2], const Unit& u, int wr, int wc, int fr, int fq) const {
        const int row0 = u.pm * BM + wr * 64 + fr, col0 = u.pn * BM + wc * 32 + 8 * fq;
        const int seg = lora ? (u.pn >> 1) : 4;
        f32x4 bv[2][2];
#pragma unroll
        for (int bj = 0; bj < 2; ++bj)
#pragma unroll
            for (int n = 0; n < 2; ++n) {
                bv[bj][n] = (f32x4){0.f, 0.f, 0.f, 0.f};
                if (seg < 4) { const int cc = (col0 + bj * HALF + 4 * n) & 511; const float* bp = (seg < 2) ? (w0 + seg * 512 + cc) : (a0 + (seg - 2) * 512 + cc); bv[bj][n] = *(const f32x4*)bp; }
            }
        const float mul = (seg < 2) ? 0.6065306597126334f : 1.0f;
#pragma unroll
        for (int ai = 0; ai < 2; ++ai)
#pragma unroll
            for (int m = 0; m < 4; ++m) { bf16_t* rowp = O + (size_t)(row0 + ai * HALF + m * 16) * ldc + col0;
#pragma unroll
                for (int bj = 0; bj < 2; ++bj) { f32x4 v0 = acc[ai][bj][m][0], v1 = acc[ai][bj][m][1];
                    if (seg < 4) { v0 = v0 + bv[bj][0]; v1 = v1 + bv[bj][1];
#pragma unroll
                        for (int e = 0; e < 4; ++e) { v0[e] = mul * sigm_(v0[e]); v1[e] = mul * sigm_(v1[e]); } }
                    u32x4 w; w.x = cvt_pk_bf16(v0[0], v0[1]); w.y = cvt_pk_bf16(v0[2], v0[3]); w.z = cvt_pk_bf16(v1[0], v1[1]); w.w = cvt_pk_bf16(v1[2], v1[3]);
                    *(u32x4*)(rowp + bj * HALF) = w; } }
    }
};
struct EpiSwiglu {
    static constexpr bool PERM = true, AFTER_DRAIN = false;
    bf16_t* O; int ldc;
    __device__ __forceinline__ void operator()(const f32x4 (&acc)[2][2][4][2], const Unit& u, int wr, int wc, int fr, int fq) const {
        const int row0 = u.pm * BM + wr * 64 + fr, col0 = u.pn * HALF + wc * 32 + 8 * fq;
#pragma unroll
        for (int ai = 0; ai < 2; ++ai)
#pragma unroll
            for (int m = 0; m < 4; ++m) { bf16_t* rowp = O + (size_t)(row0 + ai * HALF + m * 16) * ldc + col0;
                f32x4 h0, h1;
#pragma unroll
                for (int e = 0; e < 4; ++e) { const float a0_ = acc[ai][0][m][0][e], a1_ = acc[ai][0][m][1][e];
                    h0[e] = a0_ * sigm_(a0_) * acc[ai][1][m][0][e]; h1[e] = a1_ * sigm_(a1_) * acc[ai][1][m][1][e]; }
                u32x4 w; w.x = cvt_pk_bf16(h0[0], h0[1]); w.y = cvt_pk_bf16(h0[2], h0[3]); w.z = cvt_pk_bf16(h1[0], h1[1]); w.w = cvt_pk_bf16(h1[2], h1[3]);
                *(u32x4*)rowp = w; }
    }
};
struct EpiResid {
    static constexpr bool PERM = false, AFTER_DRAIN = false;
    const float* Yin; float* Yout; int ldc; const float* gate; const float* colscale;
    __device__ __forceinline__ void operator()(const f32x4 (&acc)[2][2][4][2], const Unit& u, int wr, int wc, int fr, int fq) const {
        const int set = u.pm < 32 ? 0 : 1 + ((u.pm - 32) >> 3);
        const float* gp = gate + set * 6144;
        const int col0 = u.pn * BM + wc * 32 + 4 * fq;
#pragma unroll
        for (int bj = 0; bj < 2; ++bj)
#pragma unroll
            for (int n = 0; n < 2; ++n) { const int c = col0 + bj * HALF + n * 16;
                f32x4 gv = *(const f32x4*)(gp + c); if (colscale) gv = gv * *(const f32x4*)(colscale + c);
#pragma unroll
                for (int ai = 0; ai < 2; ++ai)
#pragma unroll
                    for (int m = 0; m < 4; ++m) { const size_t off = (size_t)(u.pm * BM + ai * HALF + wr * 64 + m * 16 + fr) * ldc + c;
                        const f32x4 bs = *(const f32x4*)(Yin + off); *(f32x4*)(Yout + off) = bs + gv * acc[ai][bj][m][n]; } }
    }
};

template <class Epi, class Sched, bool ALIGN_EPI = false, bool SP2 = false>
__device__ __forceinline__ void gemm_phase(PG8_LAS unsigned char* lds, const Gemm g, const Sched& S, const Epi& E, const int tid) {
    const int wid = __builtin_amdgcn_readfirstlane(tid >> 6), lane = tid & 63, wr = wid >> 2, wc = wid & 3, fr = lane & 15, fq = lane >> 4;
    const int K = g.K, nt = K / BK;
    unsigned voffA[2], voffB[2];
#pragma unroll
    for (int i = 0; i < 2; ++i) { int R, C; stage_rc(tid * 16 + i * 8192, R, C); const int Rb = Epi::PERM ? ((R & ~31) + perm32(R & 31)) : R;
        voffA[i] = (unsigned)(R * g.lda + C) * 2u; voffB[i] = (unsigned)(Rb * K + C) * 2u; }
    const size_t kstep = (size_t)(BK * 2);
    const size_t hstepA = (size_t)HALF * g.lda * 2, hstepB = (size_t)HALF * K * 2;
    const size_t tstepA = 2 * hstepA, tstepB = 2 * hstepB;
    const size_t apn = (size_t)g.a_pn_off * 2;
    const unsigned ldsw = (unsigned)wid * 1024u;
    const int aoff = lds_byte(wr * 64 + fr, fq * 8), boff = lds_byte(wc * 32 + fr, fq * 8);
#define PG8_SA(b, h) (((b) * 2 + (h)) * HTB)
#define PG8_SB(b, h) ((4 + (b) * 2 + (h)) * HTB)
#define PG8_STAGE(bufoff, gbase, voff) do { _Pragma("unroll") for (int _i = 0; _i < 2; ++_i) \
        __builtin_amdgcn_global_load_lds((const unsigned*)((const char*)(gbase) + (voff)[_i]), (PG8_LAS unsigned*)(lds + (bufoff) + ldsw + _i * 8192), 16, 0, 0); } while (0)
#define PG8_LDA(dst, b, h) do { _Pragma("unroll") for (int m = 0; m < 4; ++m) _Pragma("unroll") for (int k = 0; k < 2; ++k) dst[m][k] = *(const PG8_LAS bf16x8*)(lds + PG8_SA(b, h) + aoff + m * 2048 + k * 1024); } while (0)
#define PG8_LDB(dst, b, h) do { _Pragma("unroll") for (int n = 0; n < 2; ++n) _Pragma("unroll") for (int k = 0; k < 2; ++k) dst[n][k] = *(const PG8_LAS bf16x8*)(lds + PG8_SB(b, h) + boff + n * 2048 + k * 1024); } while (0)
#define PG8_MMA(ai, bj, At, Bt) do { __builtin_amdgcn_s_setprio(1); _Pragma("unroll") for (int m = 0; m < 4; ++m) _Pragma("unroll") for (int n = 0; n < 2; ++n) _Pragma("unroll") for (int k = 0; k < 2; ++k) \
        acc[ai][bj][m][n] = __builtin_amdgcn_mfma_f32_16x16x32_bf16(Bt[n][k], At[m][k], acc[ai][bj][m][n], 0, 0, 0); __builtin_amdgcn_s_setprio(0); } while (0)
#define PG8_WAIT_V(n) asm volatile("s_waitcnt vmcnt(" #n ")" ::: "memory")
#define PG8_WAIT_L(n) asm volatile("s_waitcnt lgkmcnt(" #n ")" ::: "memory")
#define PG8_BAR __builtin_amdgcn_s_barrier()
#define PG8_SCHED __builtin_amdgcn_sched_barrier(0)
    Unit cur, nxt; int ui = 0;
    if (!S.next(0, cur)) return;
    f32x4 acc[2][2][4][2];
#pragma unroll
    for (int a = 0; a < 2; ++a)
#pragma unroll
        for (int b = 0; b < 2; ++b)
#pragma unroll
            for (int m = 0; m < 4; ++m)
#pragma unroll
                for (int n = 0; n < 2; ++n) acc[a][b][m][n] = (f32x4){0.f, 0.f, 0.f, 0.f};
    bf16x8 At[4][2], B0[2][2], B1[2][2];
    const char* cA = (const char*)g.A + (size_t)cur.pm * tstepA + (size_t)cur.pn * apn; const char* cB = (const char*)g.Bt + (size_t)cur.pn * tstepB;
    S.a_ready(cur);
    if constexpr (SP2) {
        PG8_STAGE(PG8_SB(0, 0), cB, voffB); PG8_STAGE(PG8_SB(0, 1), cB + hstepB, voffB); PG8_STAGE(PG8_SA(0, 0), cA, voffA); PG8_STAGE(PG8_SA(0, 1), cA + hstepA, voffA);
        if (wr == 1) PG8_BAR;
        PG8_WAIT_V(2); PG8_BAR;
        PG8_STAGE(PG8_SB(1, 0), cB + kstep, voffB); PG8_STAGE(PG8_SA(1, 0), cA + kstep, voffA); PG8_STAGE(PG8_SB(1, 1), cB + hstepB + kstep, voffB);
        PG8_WAIT_V(6); PG8_BAR;
    } else {
        PG8_STAGE(PG8_SB(0, 0), cB, voffB); PG8_STAGE(PG8_SA(0, 0), cA, voffA); PG8_STAGE(PG8_SB(0, 1), cB + hstepB, voffB); PG8_STAGE(PG8_SA(0, 1), cA + hstepA, voffA);
        if (wr == 1) PG8_BAR;
        PG8_WAIT_V(4); PG8_BAR;
        PG8_STAGE(PG8_SB(1, 0), cB + kstep, voffB); PG8_STAGE(PG8_SA(1, 0), cA + kstep, voffA); PG8_STAGE(PG8_SB(1, 1), cB + hstepB + kstep, voffB);
        PG8_WAIT_V(6); PG8_BAR;
    }
    for (;;) {
        const bool has_next = S.next(ui + 1, nxt);
        const char* nA = has_next ? (const char*)g.A + (size_t)nxt.pm * tstepA + (size_t)nxt.pn * apn : cA; const char* nB = has_next ? (const char*)g.Bt + (size_t)nxt.pn * tstepB : cB;
        for (int t = 0; t < nt; t += 2) {
            const bool last = (t == nt - 2);
            const char* a1 = cA + (size_t)(t + 1) * kstep;
            const char* a2 = last ? nA : cA + (size_t)(t + 2) * kstep; const char* b2 = last ? nB : cB + (size_t)(t + 2) * kstep;
            const char* a3 = a2 + kstep; const char* b3 = b2 + kstep;
            if (last && has_next) S.a_ready(nxt);
            if constexpr (SP2) {
            PG8_LDB(B0, 0, 0); PG8_LDB(B1, 0, 1); PG8_SCHED; PG8_LDA(At, 0, 0); PG8_STAGE(PG8_SA(1, 1), a1 + hstepA, voffA);
            PG8_WAIT_V(8); PG8_WAIT_L(0); PG8_BAR; PG8_MMA(0, 0, At, B0); PG8_MMA(0, 1, At, B1); PG8_BAR; PG8_SCHED;
            PG8_LDA(At, 0, 1); PG8_STAGE(PG8_SB(0, 0), b2, voffB); PG8_STAGE(PG8_SB(0, 1), b2 + hstepB, voffB); PG8_STAGE(PG8_SA(0, 0), a2, voffA);
            PG8_WAIT_V(8); PG8_WAIT_L(0); PG8_BAR; PG8_MMA(1, 0, At, B0); PG8_MMA(1, 1, At, B1); PG8_BAR; PG8_SCHED;
            PG8_LDB(B0, 1, 0); PG8_LDB(B1, 1, 1); PG8_SCHED; PG8_LDA(At, 1, 0); PG8_STAGE(PG8_SA(0, 1), a2 + hstepA, voffA);
            PG8_WAIT_V(8); PG8_WAIT_L(0); PG8_BAR; PG8_MMA(0, 0, At, B0); PG8_MMA(0, 1, At, B1); PG8_BAR; PG8_SCHED;
            PG8_LDA(At, 1, 1); PG8_STAGE(PG8_SB(1, 0), b3, voffB); PG8_STAGE(PG8_SB(1, 1), b3 + hstepB, voffB); PG8_STAGE(PG8_SA(1, 0), a3, voffA);
            PG8_WAIT_V(8); PG8_WAIT_L(0); PG8_BAR; PG8_MMA(1, 0, At, B0); PG8_MMA(1, 1, At, B1); PG8_BAR; PG8_SCHED;
            } else {
            PG8_LDB(B0, 0, 0); PG8_SCHED; PG8_LDA(At, 0, 0); PG8_STAGE(PG8_SA(1, 1), a1 + hstepA, voffA);
            PG8_WAIT_L(8); PG8_BAR; PG8_WAIT_L(0); PG8_MMA(0, 0, At, B0); PG8_BAR; PG8_SCHED;
            PG8_LDB(B1, 0, 1); PG8_STAGE(PG8_SB(0, 0), b2, voffB);
            PG8_BAR; PG8_WAIT_L(0); PG8_MMA(0, 1, At, B1); PG8_BAR;
            PG8_LDA(At, 0, 1); PG8_STAGE(PG8_SA(0, 0), a2, voffA);
            PG8_BAR; PG8_WAIT_L(0); PG8_MMA(1, 0, At, B0); PG8_BAR; PG8_SCHED;
            PG8_STAGE(PG8_SB(0, 1), b2 + hstepB, voffB);
            PG8_WAIT_V(6); PG8_BAR; PG8_MMA(1, 1, At, B1); PG8_BAR;
            PG8_LDB(B0, 1, 0); PG8_SCHED; PG8_LDA(At, 1, 0); PG8_STAGE(PG8_SA(0, 1), a2 + hstepA, voffA);
            PG8_WAIT_L(8); PG8_BAR; PG8_WAIT_L(0); PG8_MMA(0, 0, At, B0); PG8_BAR; PG8_SCHED;
            PG8_LDB(B1, 1, 1); PG8_STAGE(PG8_SB(1, 0), b3, voffB);
            PG8_BAR; PG8_WAIT_L(0); PG8_MMA(0, 1, At, B1); PG8_BAR;
            PG8_LDA(At, 1, 1); PG8_STAGE(PG8_SA(1, 0), a3, voffA);
            PG8_BAR; PG8_WAIT_L(0); PG8_MMA(1, 0, At, B0); PG8_BAR; PG8_SCHED;
            PG8_STAGE(PG8_SB(1, 1), b3 + hstepB, voffB);
            PG8_WAIT_V(6); PG8_BAR; PG8_MMA(1, 1, At, B1); PG8_BAR;
            }
        }
        if constexpr (ALIGN_EPI) { if (wr == 0) PG8_BAR; }
        if constexpr (!Epi::AFTER_DRAIN) { E(acc, cur, wr, wc, fr, fq); S.done(cur); }
        if (!has_next) break;
#pragma unroll
        for (int a = 0; a < 2; ++a)
#pragma unroll
            for (int b = 0; b < 2; ++b)
#pragma unroll
                for (int m = 0; m < 4; ++m)
#pragma unroll
                    for (int n = 0; n < 2; ++n) acc[a][b][m][n] = (f32x4){0.f, 0.f, 0.f, 0.f};
        cur = nxt; cA = nA; cB = nB; ++ui;
        if constexpr (ALIGN_EPI) { if (wr == 1) PG8_BAR; }
    }
    PG8_WAIT_V(0);
    if constexpr (!ALIGN_EPI) { if (wr == 0) PG8_BAR; }
    PG8_BAR;
    if constexpr (Epi::AFTER_DRAIN) { E.fused(acc, cur, wr, wc, fr, fq, lds, wid, lane); S.done(cur); }
#undef PG8_SA
#undef PG8_SB
#undef PG8_STAGE
#undef PG8_LDA
#undef PG8_LDB
#undef PG8_MMA
#undef PG8_WAIT_V
#undef PG8_WAIT_L
#undef PG8_BAR
#undef PG8_SCHED
}
}
#define XB_TMO      128
#define XB_XCNT(j)  (256  + 64 * (j))
#define XB_XSUB(j)  (1280 + 64 * (j))
#define XB_XGEN(j)  (2304 + 64 * (j))
#define XB_TOP      3328
#define XB_TOPGEN   3392
#define XCD_BAR_WORDS 3456
#define XB_SPIN_CAP (1u << 18)

__device__ __forceinline__ unsigned xb_ld(unsigned* p)              { return __hip_atomic_load(p, __ATOMIC_RELAXED, __HIP_MEMORY_SCOPE_AGENT); }
__device__ __forceinline__ unsigned xb_add(unsigned* p, unsigned v) { return __hip_atomic_fetch_add(p, v, __ATOMIC_RELAXED, __HIP_MEMORY_SCOPE_AGENT); }
__device__ __forceinline__ unsigned xb_xcc_id() { return (unsigned)__builtin_amdgcn_s_getreg((3 << 11) | 20) & 0xFu; }
#define XB_SPIN(cond, bar) do { unsigned _sp = 0; while (cond) { __builtin_amdgcn_s_sleep(1); \
    if ((++_sp & 255u) == 0u) { if (xb_ld(&(bar)[XB_TMO])) break; if (_sp > XB_SPIN_CAP) { atomicAdd(&(bar)[XB_TMO], 1u); break; } } } } while (0)

struct XcdBarrier {
    unsigned* bar; unsigned x;
    volatile LAS unsigned* st;
};

__device__ __forceinline__ XcdBarrier xcd_barrier_post(unsigned* bar, volatile LAS unsigned* st) {
    XcdBarrier b; b.bar = bar; b.x = xb_xcc_id(); b.st = st;
    if (threadIdx.x == 0) (void)xb_add(&bar[XB_XCNT(b.x)], 1u);
    return b;
}
__device__ __forceinline__ void xcd_barrier_complete(unsigned* bar, unsigned x, unsigned& nloc, unsigned& nx) {
    const unsigned G = gridDim.x * gridDim.y * gridDim.z;
    unsigned sum, cnt, mine, sp = 0u;
    for (;;) {
        sum = 0u; cnt = 0u; mine = 0u;
#pragma unroll
        for (unsigned j = 0; j < 16; ++j) { const unsigned c = xb_ld(&bar[XB_XCNT(j)]); sum += c; cnt += (c > 0u) ? 1u : 0u; mine = (j == x) ? c : mine; }
        if (sum == G) break;
        __builtin_amdgcn_s_sleep(1);
        if ((++sp & 255u) == 0u) { if (xb_ld(&bar[XB_TMO])) break; if (sp > XB_SPIN_CAP) { atomicAdd(&bar[XB_TMO], 1u); break; } }
    }
    nloc = mine > 0u ? mine : 1u; nx = cnt > 0u ? cnt : 1u;
}

__device__ __forceinline__ void xcd_barrier(const XcdBarrier& b) {
    asm volatile("s_waitcnt vmcnt(0)" ::: "memory");
    __syncthreads();
    if (threadIdx.x == 0) {
        unsigned* bar = b.bar;
        __builtin_amdgcn_s_waitcnt(0);
        unsigned nloc = b.st[0], nx = b.st[1];
        if (nloc == 0u) { xcd_barrier_complete(bar, b.x, nloc, nx); b.st[0] = nloc; b.st[1] = nx; }
        const unsigned old = xb_add(&bar[XB_XSUB(b.x)], 1u);
        const unsigned gen = old / nloc;
        if (old + 1u == (gen + 1u) * nloc) {
            __builtin_amdgcn_fence(__ATOMIC_RELEASE, "agent");
            asm volatile("s_waitcnt vmcnt(0)" ::: "memory");
            const unsigned og = xb_add(&bar[XB_TOP], 1u);
            const unsigned tg = og / nx;
            if (og + 1u == (tg + 1u) * nx) xb_add(&bar[XB_TOPGEN], 1u);
            else XB_SPIN(xb_ld(&bar[XB_TOPGEN]) == tg, bar);
            __builtin_amdgcn_fence(__ATOMIC_ACQUIRE, "agent");
            xb_add(&bar[XB_XGEN(b.x)], 1u);
            asm volatile("s_waitcnt vmcnt(0)" ::: "memory");
        } else {
            XB_SPIN(xb_ld(&bar[XB_XGEN(b.x)]) == gen, bar);
            __builtin_amdgcn_fence(__ATOMIC_ACQUIRE, "agent");
            asm volatile("s_waitcnt vmcnt(0)" ::: "memory");
        }
    }
    __syncthreads();
}

struct Args { const float* in[N_IN]; float* out; unsigned char* ws; int ph_lo, ph_hi, use_bar, pad; };
typedef const float* cfp_t;
typedef const __attribute__((address_space(4))) cfp_t* KIn;
struct P { KIn in; float* out; unsigned char* ws; };

#define LDS_WAIT() asm volatile("s_waitcnt lgkmcnt(0)" ::: "memory")

DI void transpose_item(const float* src, int src_ld, int k0, int n0, bf16_t* dst, int dst_ld, int dst_row0, int dst_col0, LAS float* scr, int lane) {
#pragma unroll 8
    for (int i = 0; i < 32; ++i) { const int kk = 2 * i + (lane >> 5); scr[kk * 33 + (lane & 31)] = src[(size_t)(k0 + kk) * src_ld + n0 + (lane & 31)]; }
    LDS_WAIT(); asm volatile("" ::: "memory");
    const int c = lane & 7;
#pragma unroll
    for (int j = 0; j < 4; ++j) { const int n = (lane >> 3) + 8 * j; const LAS float* s = scr + (8 * c) * 33 + n;
        u32x4 o; o.x = pk2(s[0 * 33], s[1 * 33]); o.y = pk2(s[2 * 33], s[3 * 33]); o.z = pk2(s[4 * 33], s[5 * 33]); o.w = pk2(s[6 * 33], s[7 * 33]);
        *(u32x4*)(dst + (size_t)(dst_row0 + n) * dst_ld + dst_col0 + 8 * c) = o; }
    LDS_WAIT(); asm volatile("" ::: "memory");
}
DI void zero_item(bf16_t* dst, int dst_ld, int dst_row0, int dst_col0, int lane) {
#pragma unroll
    for (int j = 0; j < 4; ++j) { const int n = (lane >> 3) + 8 * j; *(u32x4*)(dst + (size_t)(dst_row0 + n) * dst_ld + dst_col0 + 8 * (lane & 7)) = (u32x4){0u, 0u, 0u, 0u}; }
}

DI void phase_p0(const P& a, LAS unsigned char* lds, int tid, int lane, int wave, int G, int bid) {
    unsigned char* ws = a.ws;
    {
        LAS float* red = (LAS float*)lds;
        float* MOD = (float*)(ws + WS_MOD);
        const float* adaw = a.in[I_ADAW]; const float* adab = a.in[I_ADAB]; const float* cctx = a.in[I_CCTX]; const float* cc = a.in[I_C];
        for (int u = bid; u < 4 * 96; u += G) {
            const int l = u / 96, n = (u % 96) * 64 + lane;
            const float* W = adaw + (size_t)l * 1024 * 6144 + n;
            const int k0 = wave * 128;
            float s0 = 0.f, s1 = 0.f, s2 = 0.f;
#pragma unroll 8
            for (int kk = 0; kk < 128; ++kk) { const int k = k0 + kk; const float w = W[(size_t)k * 6144];
                s0 += siluf(cctx[k]) * w; s1 += siluf(cc[k]) * w; s2 += siluf(cc[1024 + k]) * w; }
            red[(wave * 3 + 0) * 64 + lane] = s0; red[(wave * 3 + 1) * 64 + lane] = s1; red[(wave * 3 + 2) * 64 + lane] = s2;
            __syncthreads();
            if (tid < 192) { const int s = tid >> 6, ln = tid & 63; float t = 0.f;
#pragma unroll
                for (int w8 = 0; w8 < 8; ++w8) t += red[(w8 * 3 + s) * 64 + ln];
                const int nn = (u % 96) * 64 + ln;
                MOD[(size_t)(l * 3 + s) * 6144 + nn] = t + adab[l * 6144 + nn]; }
            __syncthreads();
        }
    }
    {
        const f32x4* xp = (const f32x4*)a.in[I_XP]; const f32x4* xs = (const f32x4*)a.in[I_XS]; f32x4* y = (f32x4*)(a.out + OUT_Y);
        const int n4p = NCTX * 256, n4 = NT * 256;
        for (int i = bid * NTHR + tid; i < n4; i += G * NTHR) y[i] = (i < n4p) ? xp[i] : xs[i - n4p];
    }
    {
        LAS float* scr = (LAS float*)(lds + 8192 + wave * 8448);
        const int gw = bid * NWAVES + wave, NGW = G * NWAVES;
        constexpr int C_IN = 16 * 78, C_OUT = 16 * 32, C_W1 = 16 * 88, C_W2 = 44 * 32, C_UQ = 6 * 24, C_UKV = 4 * 32, C_POOL = 4 * 8, C_LORA = 320, C_ZP = 32;
        constexpr int NITEMS = 2 * C_IN + 2 * C_OUT + 8 * C_W1 + 4 * C_W2 + 2 * C_UQ + 2 * C_UKV + 8 * C_POOL + 2 * C_LORA + 2 * C_ZP;
        for (int it = gw; it < NITEMS; it += NGW) {
            int r = it;
            if (r < 2 * C_IN) { const int i = r / C_IN; r %= C_IN; const int kb = r / 78, nb = r % 78;
                transpose_item(a.in[I_INW] + (size_t)i * 1024 * IN_DIM, IN_DIM, 64 * kb, 32 * nb, (bf16_t*)(ws + WS_WINT) + (size_t)i * IN_PAD * 1024, 1024, 32 * nb, 64 * kb, scr, lane); continue; }
            r -= 2 * C_IN;
            if (r < 2 * C_OUT) { const int i = r / C_OUT; r %= C_OUT; const int kb = r / 32, nb = r % 32;
                transpose_item(a.in[I_OUTW] + (size_t)i * 1024 * 1024, 1024, 64 * kb, 32 * nb, (bf16_t*)(ws + WS_WOUTT) + (size_t)i * 1024 * 1024, 1024, 32 * nb, 64 * kb, scr, lane); continue; }
            r -= 2 * C_OUT;
            if (r < 8 * C_W1) { const int lw = r / C_W1; r %= C_W1; const int l = lw >> 1, which = lw & 1; const int kb = r / 88, nb = r % 88; const int n0 = 32 * nb;
                const float* src = (which ? a.in[I_W3] : a.in[I_W1]) + (size_t)l * 1024 * DFF;
                transpose_item(src, DFF, 64 * kb, n0, (bf16_t*)(ws + WS_W13T) + (size_t)l * 5632 * 1024, 1024, (n0 >> 7) * 256 + which * 128 + (n0 & 127), 64 * kb, scr, lane); continue; }
            r -= 8 * C_W1;
            if (r < 4 * C_W2) { const int l = r / C_W2; r %= C_W2; const int kb = r / 32, nb = r % 32;
                transpose_item(a.in[I_W2] + (size_t)l * DFF * 1024, 1024, 64 * kb, 32 * nb, (bf16_t*)(ws + WS_W2T) + (size_t)l * 1024 * DFF, DFF, 32 * nb, 64 * kb, scr, lane); continue; }
            r -= 4 * C_W2;
            if (r < 2 * C_UQ) { const int i = r / C_UQ; r %= C_UQ; const int kb = r / 24, nb = r % 24;
                transpose_item(a.in[I_UQW] + (size_t)i * 384 * 768, 768, 64 * kb, 32 * nb, (bf16_t*)(ws + WS_WUQT) + (size_t)i * 768 * 384, 384, 32 * nb, 64 * kb, scr, lane); continue; }
            r -= 2 * C_UQ;
            if (r < 2 * C_UKV) { const int i = r / C_UKV; r %= C_UKV; const int kb = r / 32, nb = r % 32;
                transpose_item(a.in[I_UKVW] + (size_t)i * 256 * 1024, 1024, 64 * kb, 32 * nb, (bf16_t*)(ws + WS_WUKVT) + (size_t)i * 1024 * 256, 256, 32 * nb, 64 * kb, scr, lane); continue; }
            r -= 2 * C_UKV;
            if (r < 8 * C_POOL) { const int jg = r / C_POOL; r %= C_POOL; const int j = jg >> 2, g = jg & 3; const int kb = r / 8, nb = r % 8;
                transpose_item(a.in[I_POOLW] + (size_t)jg * 256 * 256, 256, 64 * kb, 32 * nb, (bf16_t*)(ws + WS_POOLT) + (size_t)j * 1024 * 256, 256, g * 256 + 32 * nb, 64 * kb, scr, lane); continue; }
            r -= 8 * C_POOL;
            if (r < 2 * C_LORA) { const int i = r / C_LORA; r %= C_LORA; const int rb = r >> 2, cb = r & 3; const int seg = rb >> 4, n0 = (rb & 15) * 32;
                bf16_t* dst = (bf16_t*)(ws + WS_WLORAT) + (size_t)i * IN_PAD * 256;
                if (seg < 2 && cb == 0) transpose_item(a.in[I_WUP] + (size_t)(i * 2 + seg) * 64 * 512, 512, 0, n0, dst, 256, rb * 32, 0, scr, lane);
                else if (seg >= 2 && seg < 4 && cb == 1) transpose_item(a.in[I_AUP] + (size_t)(i * 2 + seg - 2) * 64 * 512, 512, 0, n0, dst, 256, rb * 32, 64, scr, lane);
                else if (seg == 4 && cb >= 2) transpose_item(a.in[I_GUP] + (size_t)i * 128 * 512, 512, (cb - 2) * 64, n0, dst, 256, rb * 32, cb * 64, scr, lane);
                else zero_item(dst, 256, rb * 32, cb * 64, lane);
                continue; }
            r -= 2 * C_LORA;
            { const int i = r / C_ZP; r %= C_ZP; const int rb = r >> 4, cb = r & 15;
              zero_item((bf16_t*)(ws + WS_WINT) + (size_t)i * IN_PAD * 1024, 1024, IN_DIM + rb * 32, cb * 64, lane); }
        }
    }
}

DI void phase_norm(const float* Y, const float* gvec, const float* modl, int shift_idx, int scale_idx, bf16_t* XN, float* RS, int mode, int lane, int wave, int G, int bid) {
    const int gw = bid * NWAVES + wave, NGW = G * NWAVES;
    for (int row = gw; row < NT; row += NGW) {
        const f32x4* xr = (const f32x4*)(Y + (size_t)row * D) + lane;
        f32x4 v[4]; float s = 0.f;
#pragma unroll
        for (int j = 0; j < 4; ++j) { v[j] = xr[64 * j]; s += (v[j].x * v[j].x + v[j].y * v[j].y) + (v[j].z * v[j].z + v[j].w * v[j].w); }
        const float rstd = rsqrtf(wave_sum(s) * (1.f / D) + EPS);
        if (mode == 1) { if (lane == 0) RS[row] = rstd; continue; }
        const float* mp = modl + mod_set(row) * 6144;
        const f32x4* gp = (const f32x4*)gvec + lane; const f32x4* shp = (const f32x4*)(mp + shift_idx * 1024) + lane; const f32x4* scp = (const f32x4*)(mp + scale_idx * 1024) + lane;
        u32x2* o8 = (u32x2*)(XN + (size_t)row * D) + lane;
#pragma unroll
        for (int j = 0; j < 4; ++j) { const f32x4 g = gp[64 * j], sh = shp[64 * j], sc = scp[64 * j];
            const f32x4 h = v[j] * rstd * g * (sc + 1.f) + sh;
            u32x2 w; w.x = pk2(h.x, h.y); w.y = pk2(h.z, h.w); o8[64 * j] = w; }
    }
}

DI void rope8(float* x, const float* px, int q8, int t) {
    const int half = q8 >> 2, q4 = q8 & 3; const float pos = half ? (float)(t & 63) : (float)(t >> 6);
    const int f0 = 8 * (q4 & 1);
#pragma unroll
    for (int e = 0; e < 8; ++e) { const float fr = exp2f(-(float)(f0 + e) * (13.287712379549449f / 16.f)); float sn, cs; sincosf(pos * fr, &sn, &cs);
        x[e] = (q4 < 2) ? (x[e] * cs - px[e] * sn) : (x[e] * cs + px[e] * sn); }
}

DI void phase_r1(const P& a, int i, int lane, int wave, int G, int bid) {
    unsigned char* ws = a.ws;
    const bf16_t* PROJ = (const bf16_t*)(ws + WS_BIG);
    bf16_t* RB = (bf16_t*)(ws + WS_RB); bf16_t* KB = (bf16_t*)(ws + WS_KB); bf16_t* VB = (bf16_t*)(ws + WS_VB); bf16_t* KKB = (bf16_t*)(ws + WS_KKB);
    bf16_t* Lm = (bf16_t*)(ws + WS_L); bf16_t* CQ = (bf16_t*)(ws + WS_CQ); bf16_t* CKV = (bf16_t*)(ws + WS_CKV); bf16_t* KRB = (bf16_t*)(ws + WS_KRB);
    const float* mu = a.in[I_MU] + i * 1792; const float* k_k = a.in[I_KK] + i * 512;
    const float* cq_g = a.in[I_CQG] + i * 384; const float* ckv_g = a.in[I_CKVG] + i * 256; const float* kr_g = a.in[I_KRG] + i * 64;
    const int gw = bid * NWAVES + wave, NGW = G * NWAVES;
    for (int row = gw; row < NKV; row += NGW) {
        if (row >= NT) {
            const int rr = row - NT, b2 = rr >> 8, t = rr & 255;
            const f32x4 v = *((const f32x4*)(a.in[I_CCKV] + ((size_t)(b2 * 2 + i) * 256 + t) * 256) + lane);
            u32x2 w; w.x = pk2(v.x, v.y); w.y = pk2(v.z, v.w); *((u32x2*)(CKV + (size_t)row * 256) + lane) = w;
            if (lane < 16) { const f32x4 k4 = *((const f32x4*)(a.in[I_CKR] + ((size_t)(b2 * 2 + i) * 256 + t) * 64) + lane);
                u32x2 w2; w2.x = pk2(k4.x, k4.y); w2.y = pk2(k4.z, k4.w); *((u32x2*)(KRB + (size_t)row * 64) + lane) = w2; }
            continue;
        }
        const bool ctx = row < NCTX; const int t = ctx ? (row & 255) : ((row - NCTX) & 2047); const int T = ctx ? TCTX : TLAT;
        const bool hp = t > 0, hn = t < T - 1;
        const bf16_t* p0 = PROJ + (size_t)row * IN_PAD;
#pragma unroll
        for (int j = 0; j < 3; ++j) {
            const int c = 512 * j + 8 * lane;
            float x0[8], xm[8], xp[8];
            unpack8(*(const u32x4*)(p0 + c), x0);
            if (hp) unpack8(*(const u32x4*)(p0 - IN_PAD + c), xm); else { for (int e = 0; e < 8; ++e) xm[e] = 0.f; }
            if (hn) unpack8(*(const u32x4*)(p0 + IN_PAD + c), xp); else { for (int e = 0; e < 8; ++e) xp[e] = 0.f; }
            const f32x4 m0 = *(const f32x4*)(mu + c), m1 = *(const f32x4*)(mu + c + 4);
            float rw[8];
#pragma unroll
            for (int e = 0; e < 8; ++e) { const float m = e < 4 ? m0[e & 3] : m1[e & 3]; rw[e] = x0[e] + m * (0.5f * (xm[e] + xp[e]) - x0[e]); }
            bf16_t* dst = (j == 0 ? RB : (j == 1 ? KB : VB));
            *(u32x4*)(dst + (size_t)row * 512 + 8 * lane) = pack8(rw);
            if (j == 1) {
                const f32x4 q0 = *(const f32x4*)(k_k + 8 * lane), q1 = *(const f32x4*)(k_k + 8 * lane + 4);
                float kk[8]; float ss = 0.f;
#pragma unroll
                for (int e = 0; e < 8; ++e) { kk[e] = rw[e] * (e < 4 ? q0[e & 3] : q1[e & 3]); ss += kk[e] * kk[e]; }
                ss += __shfl_xor(ss, 1); ss += __shfl_xor(ss, 2); ss += __shfl_xor(ss, 4);
                const float inv = 1.f / (sqrtf(ss) + 1e-12f);
#pragma unroll
                for (int e = 0; e < 8; ++e) kk[e] *= inv;
                *(u32x4*)(KKB + (size_t)row * 512 + 8 * lane) = pack8(kk);
            }
        }
        float cqa[8]; float ssq = 0.f;
        {
            const int c = 1536 + 8 * lane;
            float x0[8]; unpack8(*(const u32x4*)(p0 + c), x0);
            if (lane < 32) {
                float xm[8], xp[8];
                if (hp) unpack8(*(const u32x4*)(p0 - IN_PAD + c), xm); else { for (int e = 0; e < 8; ++e) xm[e] = 0.f; }
                if (hn) unpack8(*(const u32x4*)(p0 + IN_PAD + c), xp); else { for (int e = 0; e < 8; ++e) xp[e] = 0.f; }
                const f32x4 m0 = *(const f32x4*)(mu + c), m1 = *(const f32x4*)(mu + c + 4);
                float lv[8];
#pragma unroll
                for (int e = 0; e < 8; ++e) { const float m = e < 4 ? m0[e & 3] : m1[e & 3]; const float rwv = x0[e] + m * (0.5f * (xm[e] + xp[e]) - x0[e]);
                    lv[e] = lane < 8 ? tanhf(rwv) : (lane < 16 ? rwv : sigm(rwv)); }
                *(u32x4*)(Lm + (size_t)row * 256 + 8 * lane) = pack8(lv);
#pragma unroll
                for (int e = 0; e < 8; ++e) cqa[e] = 0.f;
            } else {
#pragma unroll
                for (int e = 0; e < 8; ++e) { cqa[e] = x0[e]; ssq += x0[e] * x0[e]; }
            }
        }
        float xb[8]; unpack8(*(const u32x4*)(p0 + 2048 + 8 * lane), xb);
        float sb = 0.f;
#pragma unroll
        for (int e = 0; e < 8; ++e) sb += xb[e] * xb[e];
        const float tq = wave_sum(ssq + (lane < 16 ? sb : 0.f));
        const float tkv = wave_sum((lane >= 16 && lane < 48) ? sb : 0.f);
        const float tkr = wave_sum((lane >= 48 && lane < 56) ? sb : 0.f);
        const float rq = rsqrtf(tq * (1.f / 384.f) + EPS), rkv = rsqrtf(tkv * (1.f / 256.f) + EPS), rkr = rsqrtf(tkr * (1.f / 64.f) + EPS);
        if (lane >= 32) { const int ci = 8 * (lane - 32); float o[8];
#pragma unroll
            for (int e = 0; e < 8; ++e) o[e] = cqa[e] * rq * cq_g[ci + e];
            *(u32x4*)(CQ + (size_t)row * 384 + ci) = pack8(o); }
        if (lane < 16) { const int ci = 256 + 8 * lane; float o[8];
#pragma unroll
            for (int e = 0; e < 8; ++e) o[e] = xb[e] * rq * cq_g[ci + e];
            *(u32x4*)(CQ + (size_t)row * 384 + ci) = pack8(o); }
        if (lane >= 16 && lane < 48) { const int ci = 8 * (lane - 16); float o[8];
#pragma unroll
            for (int e = 0; e < 8; ++e) o[e] = xb[e] * rkv * ckv_g[ci + e];
            *(u32x4*)(CKV + (size_t)row * 256 + ci) = pack8(o);
            if (ctx) { float* dst = a.out + OUT_CKV + ((size_t)((row >> 8) * 2 + i) * 256 + t) * 256 + ci;
                *(f32x4*)dst = (f32x4){o[0], o[1], o[2], o[3]}; *(f32x4*)(dst + 4) = (f32x4){o[4], o[5], o[6], o[7]}; } }
        { const int q8 = (lane - 48) & 7; float o[8], po[8];
#pragma unroll
            for (int e = 0; e < 8; ++e) o[e] = xb[e] * rkr * kr_g[8 * q8 + e];
#pragma unroll
            for (int e = 0; e < 8; ++e) po[e] = __shfl_xor(o[e], 2);
            if (lane >= 48 && lane < 56) {
                if (ctx) { float* dst = a.out + OUT_KR + ((size_t)((row >> 8) * 2 + i) * 256 + t) * 64 + 8 * q8;
                    *(f32x4*)dst = (f32x4){o[0], o[1], o[2], o[3]}; *(f32x4*)(dst + 4) = (f32x4){o[4], o[5], o[6], o[7]}; }
                else rope8(o, po, q8, t);
                *(u32x4*)(KRB + (size_t)row * 64 + 8 * q8) = pack8(o); } }
    }
}

DI void phase_m3(const P& a, int i, int lane, int wave, int G, int bid) {
    unsigned char* ws = a.ws;
    const bf16_t* QRAW = (const bf16_t*)(ws + WS_QRAW); const bf16_t* KVRAW = (const bf16_t*)(ws + WS_KVRAW);
    bf16_t* QF = (bf16_t*)(ws + WS_QF); bf16_t* KF = (bf16_t*)(ws + WS_KF);
    const float* qn_g = a.in[I_QNG] + i * 128; const float* qr_g = a.in[I_QRG] + i * 64; const float* kn_g = a.in[I_KNG] + i * 128;
    const int gw = bid * NWAVES + wave, NGW = G * NWAVES;
    for (int row = gw; row < NKV; row += NGW) {
#pragma unroll
        for (int j = 0; j < 2; ++j) {
            float x[8]; unpack8(*(const u32x4*)(KVRAW + (size_t)row * 1024 + 512 * j + 8 * lane), x);
            float ss = 0.f;
#pragma unroll
            for (int e = 0; e < 8; ++e) ss += x[e] * x[e];
            ss += __shfl_xor(ss, 1); ss += __shfl_xor(ss, 2); ss += __shfl_xor(ss, 4); ss += __shfl_xor(ss, 8);
            const int seg = lane >> 4;
            if ((seg & 1) == 0) { const float r = rsqrtf(ss * (1.f / 128.f) + EPS); const int h = 2 * j + (seg >> 1), ci = 8 * (lane & 15); float o[8];
#pragma unroll
                for (int e = 0; e < 8; ++e) o[e] = x[e] * r * kn_g[ci + e];
                *(u32x4*)(KF + (size_t)row * 512 + h * 128 + ci) = pack8(o); }
        }
        if (row >= NT) continue;
        const bool lat = row >= NCTX; const int t = (row - NCTX) & 2047;
#pragma unroll
        for (int j = 0; j < 2; ++j) {
            const int c = 512 * j + 8 * lane; const bool act = (j == 0) || (lane < 32);
            float x[8];
            if (act) unpack8(*(const u32x4*)(QRAW + (size_t)row * 768 + c), x); else { for (int e = 0; e < 8; ++e) x[e] = 0.f; }
            float ss = 0.f;
#pragma unroll
            for (int e = 0; e < 8; ++e) ss += x[e] * x[e];
            ss += __shfl_xor(ss, 1); ss += __shfl_xor(ss, 2); ss += __shfl_xor(ss, 4);
            const int g64 = c >> 6, part = g64 % 3;
            const float up = __shfl(ss, (lane + 8) & 63), dn = __shfl(ss, (lane - 8) & 63);
            const float tot = part == 0 ? ss + up : (part == 1 ? ss + dn : ss);
            const float r = rsqrtf(tot * (part == 2 ? (1.f / 64.f) : (1.f / 128.f)) + EPS);
            const int q8 = lane & 7;
            float o[8], po[8];
#pragma unroll
            for (int e = 0; e < 8; ++e) { const float g = part == 2 ? qr_g[8 * q8 + e] : qn_g[part * 64 + 8 * q8 + e]; o[e] = x[e] * r * g; }
#pragma unroll
            for (int e = 0; e < 8; ++e) po[e] = __shfl_xor(o[e], 2);
            if (part == 2 && lat) rope8(o, po, q8, t);
#pragma unroll
            for (int e = 0; e < 8; ++e) o[e] *= QSCALE;
            if (act) *(u32x4*)(QF + (size_t)row * 768 + c) = pack8(o);
        }
    }
}

template <int CTRL> DI float dpp_add(float x) { const int v = __builtin_amdgcn_update_dpp(0, __float_as_int(x), CTRL, 0xf, 0xf, false); return x + __int_as_float(v); }
DI float allreduce16(float x) { x = dpp_add<0x128>(x); x = dpp_add<0x124>(x); x = dpp_add<0x122>(x); x = dpp_add<0x121>(x); return x; }

DI void scan_unit(const P& a, int i, int seq, int h, int dir, int half, LAS unsigned char* lds, int tid, int lane, int wave) {
    unsigned char* ws = a.ws;
    const bf16_t* RB = (const bf16_t*)(ws + WS_RB); const bf16_t* KB = (const bf16_t*)(ws + WS_KB); const bf16_t* VB = (const bf16_t*)(ws + WS_VB); const bf16_t* KKB = (const bf16_t*)(ws + WS_KKB);
    const bf16_t* LO = (const bf16_t*)(ws + WS_BIG);
    float* Yd = (float*)(ws + WS_Y0) + (size_t)dir * NT * 512;
    const float* k_a = a.in[I_KA] + i * 512 + h * 64;
    const bool ctx = seq < 32; const int T = ctx ? TCTX : TLAT; const int tok_base = ctx ? seq * 256 : NCTX + (seq - 32) * 2048;
    LAS float* OPS = (LAS float*)lds;
    LAS float* YBUF = (LAS float*)(lds + 32 * 6 * 64 * 4);
    const int rsub = lane >> 4, kq = lane & 15, rloc = 4 * wave + rsub, row = 32 * half + rloc;
    f32x4 s;
    if (ctx) s = (f32x4){0.f, 0.f, 0.f, 0.f};
    else s = *(const f32x4*)(a.in[I_STATE] + ((((size_t)((seq - 32) * 2 + i) * 2 + dir) * 8 + h) * 64 + row) * 64 + 4 * kq);
    const int nch = T / 32;
    for (int ci = 0; ci < nch; ++ci) {
        const int c = dir ? (nch - 1 - ci) : ci; const int tok0 = tok_base + c * 32;
#pragma unroll
        for (int it = 0; it < 4; ++it) { const int e = tid + it * NTHR; const int si = e >> 6, k = e & 63; const size_t tok = (size_t)(tok0 + si); const int col = h * 64 + k;
            const float r = bf2f(RB[tok * 512 + col]), kx = bf2f(KB[tok * 512 + col]), vx = bf2f(VB[tok * 512 + col]), kkx = bf2f(KKB[tok * 512 + col]);
            const float ew = bf2f(LO[tok * IN_PAD + dir * 512 + col]), av = bf2f(LO[tok * IN_PAD + 1024 + dir * 512 + col]);
            LAS float* o = OPS + si * 384 + k;
            o[0] = __expf(-ew); o[64] = kkx; o[128] = kkx * av; o[192] = kx * (1.f + (av - 1.f) * k_a[k]); o[256] = r; o[320] = vx; }
        __syncthreads();
        for (int st = 0; st < 32; ++st) {
            const int si = dir ? (31 - st) : st;
            const LAS float* o = OPS + si * 384;
            const f32x4 w4 = *(const LAS f32x4*)(o + 4 * kq), kk4 = *(const LAS f32x4*)(o + 64 + 4 * kq), b4 = *(const LAS f32x4*)(o + 128 + 4 * kq),
                        kd4 = *(const LAS f32x4*)(o + 192 + 4 * kq), r4 = *(const LAS f32x4*)(o + 256 + 4 * kq);
            const float vv = o[320 + row];
            float d1 = (s.x * kk4.x + s.y * kk4.y) + (s.z * kk4.z + s.w * kk4.w);
            d1 = allreduce16(d1);
            s = s * w4 - d1 * b4 + vv * kd4;
            float y = (s.x * r4.x + s.y * r4.y) + (s.z * r4.z + s.w * r4.w);
            y = allreduce16(y);
            if (kq == 0) YBUF[si * 32 + rloc] = y;
        }
        __syncthreads();
#pragma unroll
        for (int it = 0; it < 2; ++it) { const int e = tid + it * NTHR; const int si = e >> 5, rl = e & 31;
            Yd[(size_t)(tok0 + si) * 512 + h * 64 + 32 * half + rl] = YBUF[e]; }
    }
    if (ctx) *(f32x4*)(a.out + OUT_STATE + ((((size_t)(seq * 2 + i) * 2 + dir) * 8 + h) * 64 + row) * 64 + 4 * kq) = s;
    __syncthreads();
}

constexpr int KLD = 200, VLD = 136;
DI int crow(int r, int hi) { return (r & 3) + 8 * (r >> 2) + 4 * hi; }
DI void attn_unit(const P& a, int seq, int h, int qb, LAS unsigned char* lds, int tid, int lane, int wave) {
    unsigned char* ws = a.ws;
    const bf16_t* QF = (const bf16_t*)(ws + WS_QF); const bf16_t* KF = (const bf16_t*)(ws + WS_KF); const bf16_t* KRB = (const bf16_t*)(ws + WS_KRB); const bf16_t* KVRAW = (const bf16_t*)(ws + WS_KVRAW);
    bf16_t* AB = (bf16_t*)(ws + WS_XN);
    const bool ctx = seq < 32; const int nkeys = ctx ? 256 : 2304;
    const int qrow0 = (ctx ? seq * 256 : NCTX + (seq - 32) * 2048 + qb * 256) + wave * 32;
    LAS bf16_t* Kl = (LAS bf16_t*)lds; LAS bf16_t* Vl = (LAS bf16_t*)(lds + 64 * KLD * 2);
    const int r32 = lane & 31, hi = lane >> 5;
    bf16x8 qf[12];
#pragma unroll
    for (int s = 0; s < 12; ++s) qf[s] = *(const bf16x8*)(QF + (size_t)(qrow0 + r32) * 768 + h * 192 + 16 * s + 8 * hi);
    f32x16 o[4];
#pragma unroll
    for (int d = 0; d < 4; ++d)
#pragma unroll
        for (int e = 0; e < 16; ++e) o[d][e] = 0.f;
    float m_run = -1e30f, l_run = 0.f;
    const int vbase = ((4 * hi + ((lane & 15) >> 2)) * VLD + 16 * ((lane >> 4) & 1) + 4 * (lane & 3)) * 2;
    for (int kt = 0; kt < nkeys / 64; ++kt) {
        const int key0 = kt * 64;
        const int kvrow0 = ctx ? seq * 256 + key0 : (key0 < 2048 ? NCTX + (seq - 32) * 2048 + key0 : NT + (seq - 32) * 256 + key0 - 2048);
        __syncthreads();
#pragma unroll
        for (int it = 0; it < 3; ++it) { const int e = tid + it * NTHR; const int kr = e / 24, ch = e % 24;
            u32x4 v;
            if (ch < 16) v = *(const u32x4*)(KF + (size_t)(kvrow0 + kr) * 512 + h * 128 + 8 * ch);
            else v = *(const u32x4*)(KRB + (size_t)(kvrow0 + kr) * 64 + 8 * (ch - 16));
            *(LAS u32x4*)(Kl + kr * KLD + 8 * ch) = v; }
#pragma unroll
        for (int it = 0; it < 2; ++it) { const int e = tid + it * NTHR; const int kr = e >> 4, ch = e & 15;
            const u32x4 v = *(const u32x4*)(KVRAW + (size_t)(kvrow0 + kr) * 1024 + h * 256 + 128 + 8 * ch);
            *(LAS u32x4*)(Vl + kr * VLD + 8 * ch) = v; }
        __syncthreads();
        f32x16 p[2];
#pragma unroll
        for (int kb = 0; kb < 2; ++kb) {
#pragma unroll
            for (int e = 0; e < 16; ++e) p[kb][e] = 0.f;
#pragma unroll
            for (int sg = 0; sg < 3; ++sg) {
                bf16x8 kf[4];
#pragma unroll
                for (int s4 = 0; s4 < 4; ++s4) kf[s4] = *(const LAS bf16x8*)(Kl + (32 * kb + r32) * KLD + 16 * (4 * sg + s4) + 8 * hi);
#pragma unroll
                for (int s4 = 0; s4 < 4; ++s4) p[kb] = __builtin_amdgcn_mfma_f32_32x32x16_bf16(kf[s4], qf[4 * sg + s4], p[kb], 0, 0, 0);
                __builtin_amdgcn_sched_barrier(0);
            }
        }
        float mx = p[0][0];
#pragma unroll
        for (int e = 1; e < 16; ++e) mx = fmaxf(mx, p[0][e]);
#pragma unroll
        for (int e = 0; e < 16; ++e) mx = fmaxf(mx, p[1][e]);
        mx = fmaxf(mx, __shfl_xor(mx, 32));
        const float m_new = fmaxf(m_run, mx); const float alpha = exp2f(m_run - m_new); m_run = m_new;
        float rs = 0.f;
#pragma unroll
        for (int kb = 0; kb < 2; ++kb)
#pragma unroll
            for (int e = 0; e < 16; ++e) { p[kb][e] = exp2f(p[kb][e] - m_new); rs += p[kb][e]; }
        l_run = l_run * alpha + rs;
#pragma unroll
        for (int d = 0; d < 4; ++d)
#pragma unroll
            for (int e = 0; e < 16; ++e) o[d][e] *= alpha;
#pragma unroll
        for (int kb = 0; kb < 2; ++kb)
#pragma unroll
            for (int s = 0; s < 2; ++s) {
                u32x4 pw; pw.x = pk2(p[kb][8 * s + 0], p[kb][8 * s + 1]); pw.y = pk2(p[kb][8 * s + 2], p[kb][8 * s + 3]); pw.z = pk2(p[kb][8 * s + 4], p[kb][8 * s + 5]); pw.w = pk2(p[kb][8 * s + 6], p[kb][8 * s + 7]);
                const bf16x8 pb = __builtin_bit_cast(bf16x8, pw);
                const int krow0 = 32 * kb + 16 * s;
#pragma unroll
                for (int d = 0; d < 4; ++d) {
                    typedef short v4i16_t __attribute__((ext_vector_type(4)));
                    const LAS unsigned char* vp = (const LAS unsigned char*)Vl + vbase + (krow0 * VLD + 32 * d) * 2;
                    const v4i16_t lo = __builtin_amdgcn_ds_read_tr16_b64_v4i16((LAS v4i16_t*)vp);
                    const v4i16_t hh = __builtin_amdgcn_ds_read_tr16_b64_v4i16((LAS v4i16_t*)(vp + 8 * VLD * 2));
                    const bf16x8 va = (bf16x8){lo[0], lo[1], lo[2], lo[3], hh[0], hh[1], hh[2], hh[3]};
                    o[d] = __builtin_amdgcn_mfma_f32_32x32x16_bf16(va, pb, o[d], 0, 0, 0);
                }
                __builtin_amdgcn_sched_barrier(0);
            }
    }
    const float lt = l_run + __shfl_xor(l_run, 32); const float inv = 1.f / lt;
    bf16_t* orow = AB + (size_t)(qrow0 + r32) * 1024 + 512 + h * 128;
#pragma unroll
    for (int d = 0; d < 4; ++d)
#pragma unroll
        for (int g = 0; g < 4; ++g) { u32x2 w; w.x = pk2(o[d][4 * g] * inv, o[d][4 * g + 1] * inv); w.y = pk2(o[d][4 * g + 2] * inv, o[d][4 * g + 3] * inv);
            *(u32x2*)(orow + 32 * d + 8 * g + 4 * hi) = w; }
    __syncthreads();
}

DI void phase_scanatt(const P& a, int i, LAS unsigned char* lds, int tid, int lane, int wave, int G, int bid) {
    const bool split = G > 128;
#ifndef T_NO_SCAN
    for (int u = bid; u < 64; u += G) scan_unit(a, i, 32 + (u >> 5), (u >> 2) & 7, (u >> 1) & 1, u & 1, lds, tid, lane, wave);
    if (split) { if (bid >= 64) for (int u = bid - 64; u < 1024; u += G - 64) scan_unit(a, i, u >> 5, (u >> 2) & 7, (u >> 1) & 1, u & 1, lds, tid, lane, wave); }
    else for (int u = bid; u < 1024; u += G) scan_unit(a, i, u >> 5, (u >> 2) & 7, (u >> 1) & 1, u & 1, lds, tid, lane, wave);
#endif
#ifndef T_NO_ATT
    if (split) {
        if (bid >= 64) { const int k = bid - 64, n = G - 64;
            for (int u = k; u < 192; u += n) { if (u < 64) attn_unit(a, 32 + (u >> 5), (u >> 3) & 3, u & 7, lds, tid, lane, wave); else attn_unit(a, (u - 64) >> 2, (u - 64) & 3, 0, lds, tid, lane, wave); } }
    } else for (int u = bid; u < 192; u += G) { if (u < 64) attn_unit(a, 32 + (u >> 5), (u >> 3) & 3, u & 7, lds, tid, lane, wave); else attn_unit(a, (u - 64) >> 2, (u - 64) & 3, 0, lds, tid, lane, wave); }
#endif
}

DI void phase_r3(const P& a, int i, int lane, int wave, int G, int bid) {
    unsigned char* ws = a.ws;
    const bf16_t* RB = (const bf16_t*)(ws + WS_RB); const bf16_t* KB = (const bf16_t*)(ws + WS_KB); const bf16_t* VB = (const bf16_t*)(ws + WS_VB);
    const bf16_t* LO = (const bf16_t*)(ws + WS_BIG); const float* Y0 = (const float*)(ws + WS_Y0); const float* Y1 = Y0 + (size_t)NT * 512;
    bf16_t* AB = (bf16_t*)(ws + WS_XN);
    const float* ln_g = a.in[I_LNG] + i * 512; const float* ln_b = a.in[I_LNB] + i * 512; const float* r_k = a.in[I_RK] + i * 512;
    const int gw = bid * NWAVES + wave, NGW = G * NWAVES; const int c = 8 * lane;
    for (int row = gw; row < NT; row += NGW) {
        const size_t o5 = (size_t)row * 512 + c;
        const f32x4 a0 = *(const f32x4*)(Y0 + o5), a1 = *(const f32x4*)(Y0 + o5 + 4), b0 = *(const f32x4*)(Y1 + o5), b1 = *(const f32x4*)(Y1 + o5 + 4);
        float y[8] = {a0.x + b0.x, a0.y + b0.y, a0.z + b0.z, a0.w + b0.w, a1.x + b1.x, a1.y + b1.y, a1.z + b1.z, a1.w + b1.w};
        float sm = 0.f;
#pragma unroll
        for (int e = 0; e < 8; ++e) sm += y[e];
        sm += __shfl_xor(sm, 1); sm += __shfl_xor(sm, 2); sm += __shfl_xor(sm, 4);
        const float mu = sm * (1.f / 64.f); float sv = 0.f;
#pragma unroll
        for (int e = 0; e < 8; ++e) { y[e] -= mu; sv += y[e] * y[e]; }
        sv += __shfl_xor(sv, 1); sv += __shfl_xor(sv, 2); sv += __shfl_xor(sv, 4);
        const float rstd = rsqrtf(sv * (1.f / 64.f) + GN_EPS);
        float r[8], k[8], v[8], g[8];
        unpack8(*(const u32x4*)(RB + o5), r); unpack8(*(const u32x4*)(KB + o5), k); unpack8(*(const u32x4*)(VB + o5), v);
        unpack8(*(const u32x4*)(LO + (size_t)row * IN_PAD + 2048 + c), g);
        float dt = 0.f;
#pragma unroll
        for (int e = 0; e < 8; ++e) dt += r[e] * k[e] * r_k[c + e];
        dt += __shfl_xor(dt, 1); dt += __shfl_xor(dt, 2); dt += __shfl_xor(dt, 4);
        float o[8];
#pragma unroll
        for (int e = 0; e < 8; ++e) o[e] = (y[e] * rstd * ln_g[c + e] + ln_b[c + e] + dt * v[e]) * g[e];
        *(u32x4*)(AB + (size_t)row * 1024 + c) = pack8(o);
    }
}

DI void phase_p1(const P& a, int l, int lane, int wave, int G, int bid) {
    unsigned char* ws = a.ws;
    const float* Y = a.out + OUT_Y; const float* RS = (const float*)(ws + WS_RS); bf16_t* Dm = (bf16_t*)(ws + WS_XN);
    const float* gvec = a.in[I_N1G] + l * 1024; const float* modl = (const float*)(ws + WS_MOD) + (size_t)l * 3 * 6144;
    const int gw = bid * NWAVES + wave, NGW = G * NWAVES;
    for (int row = gw; row < NT; row += NGW) {
        const bool ctx = row < NCTX; const int t = ctx ? (row & 255) : ((row - NCTX) & 2047); const int T = ctx ? TCTX : TLAT; const int base = row - t;
        const float* scp = modl + mod_set(row) * 6144 + 1 * 1024;
        const float rst = RS[row];
#pragma unroll
        for (int j = 0; j < 4; ++j) {
            const int hw = 1 << j;
            const int lo = max(t - hw, 0), hi = min(t + hw, T);
            const int c = 256 * j + 4 * lane;
            f32x4 sum = (f32x4){0.f, 0.f, 0.f, 0.f};
            for (int tt = lo; tt < hi; ++tt) sum += *(const f32x4*)(Y + (size_t)(base + tt) * D + c) * RS[base + tt];
            const f32x4 nt = *(const f32x4*)(Y + (size_t)row * D + c) * rst;
            const f32x4 gg = *(const f32x4*)(gvec + c) * (*(const f32x4*)(scp + c) + 1.f);
            const f32x4 d = gg * (sum * (1.f / (float)(hi - lo)) - nt);
            u32x2 w; w.x = pk2(d.x, d.y); w.y = pk2(d.z, d.w);
            *(u32x2*)(Dm + (size_t)row * D + c) = w;
        }
    }
}

constexpr int NPHASES = 35;
#ifndef DBG_LAST_PHASE
#define DBG_LAST_PHASE (NPHASES - 1)
#endif

__global__ void __launch_bounds__(NTHR, 2) mega_fwd(Args args) {
    extern __shared__ __attribute__((aligned(16))) unsigned char lds_raw[];
    LAS unsigned char* lds = (LAS unsigned char*)lds_raw;
    const int G = gridDim.x, bid = blockIdx.x;
    for (int u = threadIdx.x; u < (LDS_BYTES - LDSCTL_OFF) / 4; u += NTHR) ((LAS unsigned*)(lds + LDSCTL_OFF))[u] = 0u;
    __syncthreads();
    XcdBarrier bar; bar.bar = (unsigned*)(args.ws + WS_CTL) + 4096; bar.x = 0; bar.st = nullptr;
    if (args.use_bar) bar = xcd_barrier_post((unsigned*)(args.ws + WS_CTL) + 4096, (volatile LAS unsigned*)(lds + MISC_OFF) + 8);

    for (int ph = args.ph_lo; ph < args.ph_hi; ++ph) {
        int tid = threadIdx.x; asm volatile("" : "+v"(tid));
        const int lane = tid & 63, wave = __builtin_amdgcn_readfirstlane(tid >> 6);
        KIn inp = (KIn)__builtin_amdgcn_kernarg_segment_ptr(); asm volatile("" : "+s"(inp));
        P a; a.in = inp; a.out = (float*)inp[N_IN]; a.ws = (unsigned char*)inp[N_IN + 1];
        unsigned char* ws = a.ws;
        float* Y = a.out + OUT_Y;
        const float* MOD = (const float*)(ws + WS_MOD);
        bf16_t* XN = (bf16_t*)(ws + WS_XN);
        bf16_t* BIG = (bf16_t*)(ws + WS_BIG);
        if (ph == 0) {
#ifndef T_NO_P0
            phase_p0(a, lds, tid, lane, wave, G, bid);
#endif
        } else {
            const int p = ph - 1, blk = p / 17, rr = p % 17; const bool even = rr < 11; const int l = 2 * blk + (even ? 0 : 1), sub = even ? rr : rr - 11, i = blk;
            const float* modl = MOD + (size_t)l * 3 * 6144;
            const int kind = even ? (sub + 1) : (sub == 0 ? 12 : sub == 1 ? 13 : sub == 2 ? 14 : sub + 6);
#ifndef T_NO_MISC
            if (kind == 1) phase_norm(Y, a.in[I_N1G] + l * 1024, modl, 0, 1, XN, nullptr, 0, lane, wave, G, bid);
            else if (kind == 9) phase_norm(Y, a.in[I_N2G] + l * 1024, modl, 3, 4, XN, nullptr, 0, lane, wave, G, bid);
            else if (kind == 12) phase_norm(Y, a.in[I_N1G] + l * 1024, modl, 0, 1, XN, (float*)(ws + WS_RS), 1, lane, wave, G, bid);
            else if (kind == 3) phase_r1(a, i, lane, wave, G, bid);
            else if (kind == 5) phase_m3(a, i, lane, wave, G, bid);
#ifndef T_NO_SA
            else if (kind == 6) phase_scanatt(a, i, lds, tid, lane, wave, G, bid);
#endif
            else if (kind == 7) phase_r3(a, i, lane, wave, G, bid);
            else if (kind == 13) phase_p1(a, l, lane, wave, G, bid);
            else
#endif
#ifndef T_NO_GA
            if (kind == 2 || kind == 4) {
                const int njobs = kind == 2 ? 1 : 3;
                for (int j = 0; j < njobs; ++j) {
                    pg8::Gemm g; pg8::EpiBf16 E; E.lora = 0; E.w0 = a.in[I_W0] + i * 1024; E.a0 = a.in[I_A0] + i * 1024;
                    int rot = 0;
                    if (kind == 2) { g = pg8::Gemm{XN, (const bf16_t*)(ws + WS_WINT) + (size_t)i * IN_PAD * 1024, NT, IN_PAD, 1024, 1024, 0}; E.O = BIG; E.ldc = IN_PAD; }
                    else if (j == 0) { g = pg8::Gemm{(const bf16_t*)(ws + WS_L), (const bf16_t*)(ws + WS_WLORAT) + (size_t)i * IN_PAD * 256, NT, IN_PAD, 256, 256, 0}; E.O = BIG; E.ldc = IN_PAD; E.lora = 1; }
                    else if (j == 1) { g = pg8::Gemm{(const bf16_t*)(ws + WS_CQ), (const bf16_t*)(ws + WS_WUQT) + (size_t)i * 768 * 384, NT, 768, 384, 384, 0}; E.O = (bf16_t*)(ws + WS_QRAW); E.ldc = 768; rot = 224; }
                    else { g = pg8::Gemm{(const bf16_t*)(ws + WS_CKV), (const bf16_t*)(ws + WS_WUKVT) + (size_t)i * 1024 * 256, NKV, 1024, 256, 256, 0}; E.O = (bf16_t*)(ws + WS_KVRAW); E.ldc = 1024; rot = 112; }
                    pg8::StaticOrder S; S.init(g.M, g.N, G, (bid + rot) % G);
                    pg8::gemm_phase<pg8::EpiBf16, pg8::StaticOrder, true, true>(lds, g, S, E, tid);
                }
            } else
#endif
#ifndef T_NO_GB
            if (kind == 10) {
                pg8::Gemm g{XN, (const bf16_t*)(ws + WS_W13T) + (size_t)l * 5632 * 1024, NT, 5632, 1024, 1024, 0};
                pg8::EpiSwiglu E{BIG, DFF};
                pg8::StaticOrder S; S.init(g.M, g.N, G, bid);
                pg8::gemm_phase<pg8::EpiSwiglu, pg8::StaticOrder, true, true>(lds, g, S, E, tid);
            } else
#endif
#ifndef T_NO_GC
            if (kind == 8 || kind == 11 || kind == 14) {
                pg8::Gemm g; pg8::EpiResid E; E.Yin = Y; E.Yout = Y; E.ldc = D; E.colscale = nullptr;
                if (kind == 8) { g = pg8::Gemm{XN, (const bf16_t*)(ws + WS_WOUTT) + (size_t)i * 1024 * 1024, NT, 1024, 1024, 1024, 0}; E.gate = modl + 2 * 1024; }
                else if (kind == 11) { g = pg8::Gemm{BIG, (const bf16_t*)(ws + WS_W2T) + (size_t)l * 1024 * DFF, NT, 1024, DFF, DFF, 0}; E.gate = modl + 5 * 1024; }
                else { g = pg8::Gemm{XN, (const bf16_t*)(ws + WS_POOLT) + (size_t)(l >> 1) * 1024 * 256, NT, 1024, 256, 1024, 256}; E.gate = modl + 2 * 1024; E.colscale = a.in[I_POOLS] + (l >> 1) * 1024; }
                pg8::StaticOrder S; S.init(g.M, g.N, G, bid);
                pg8::gemm_phase<pg8::EpiResid, pg8::StaticOrder, true, true>(lds, g, S, E, tid);
            }
#endif
            {}
        }
        if (ph + 1 < args.ph_hi) { XcdBarrier b2 = bar; unsigned* bp = (unsigned*)(a.ws + WS_CTL) + 4096; asm volatile("" : "+s"(bp)); b2.bar = bp; xcd_barrier(b2); }
    }
}

#ifdef DBG_MODE
__global__ void dbg_mask(float* out, int total, int base, int period, int lo, int hi, int endb, int base2, int period2, int lo2, int hi2, int endb2, float scale) {
    for (int i = blockIdx.x * blockDim.x + threadIdx.x; i < total; i += gridDim.x * blockDim.x) {
        bool keep = false;
        if (i >= base && i < endb) { const int r = (i - base) % period; keep = (r >= lo && r < hi); }
        if (i >= base2 && i < endb2) { const int r = (i - base2) % period2; keep = keep || (r >= lo2 && r < hi2); }
        out[i] = keep ? scale * out[i] : 0.f;
    }
}
#endif

extern "C" void kernel_launch(void* const* d_in, const int* in_sizes, int n_in, void* d_out, int out_size, void* d_ws, size_t ws_size, hipStream_t stream) {
    static int grid = 0;
    if (grid == 0) {
        if (n_in != N_IN || out_size != OUT_TOTAL || ws_size < WS_END) { fprintf(stderr, "kernel_launch: unexpected shapes: n_in %d out %d ws %zu (need %zu)\n", n_in, out_size, ws_size, (size_t)WS_END); grid = -1; return; }
        int dev = 0, cus = 0;
        if (hipGetDevice(&dev) != hipSuccess || hipDeviceGetAttribute(&cus, hipDeviceAttributeMultiprocessorCount, dev) != hipSuccess) { grid = -1; return; }
        if (hipFuncSetAttribute((const void*)mega_fwd, hipFuncAttributeMaxDynamicSharedMemorySize, LDS_BYTES) != hipSuccess) { fprintf(stderr, "kernel_launch: hipFuncSetAttribute failed\n"); grid = -1; return; }
        (void)hipGetLastError();
        grid = cus;
    }
    if (grid < 0) return;
    Args a{};
    for (int k = 0; k < N_IN; ++k) a.in[k] = (const float*)d_in[k];
    a.out = (float*)d_out; a.ws = (unsigned char*)d_ws;
    (void)hipMemsetAsync((char*)d_ws + WS_CTL, 0, CTL_ZERO_BYTES, stream);
#ifndef ONE_LAUNCH
#define ONE_LAUNCH 0
#endif
    if (ONE_LAUNCH) {
        a.ph_lo = 0; a.ph_hi = DBG_LAST_PHASE + 1; a.use_bar = 1;
        hipLaunchKernelGGL(mega_fwd, dim3(grid), dim3(NTHR), LDS_BYTES, stream, a);
    } else {
        for (int ph = 0; ph <= DBG_LAST_PHASE; ++ph) { a.ph_lo = ph; a.ph_hi = ph + 1; a.use_bar = 0;
            hipLaunchKernelGGL(mega_fwd, dim3(grid), dim3(NTHR), LDS_BYTES, stream, a); }
    }
#ifdef DBG_MODE
    DBG_MASK_CALL
#endif
}
```

```cpp
#include <hip/hip_runtime.h>
#include <hip/hip_bf16.h>
#include <cstdio>
#include <cstdint>
#include <cmath>

#define DI __device__ __forceinline__
#define LAS __attribute__((address_space(3)))
#define GAS __attribute__((address_space(1)))

constexpr int D = 1024, NT = 12288, NCTX = 8192, TCTX = 256, TLAT = 2048, NKV = 12800;
constexpr int DFF = 2816, IN_DIM = 2496, IN_PAD = 2560, DA = 512;
constexpr int OUT_Y = 0, OUT_STATE = 12582912, OUT_CKV = 16777216, OUT_KR = 20971520, OUT_TOTAL = 22020096;
constexpr float EPS = 1e-6f, GN_EPS = 64e-5f;
constexpr float QSCALE = 0.07216878364870322f * 1.4426950408889634f;

enum { I_XP = 0, I_XS, I_C, I_STATE, I_CCKV, I_CKR, I_CCTX, I_N1G, I_N2G, I_ADAW, I_ADAB, I_W1, I_W3, I_W2, I_INW, I_OUTW, I_MU, I_W0, I_WUP, I_A0, I_AUP, I_GUP,
       I_KK, I_KA, I_RK, I_LNG, I_LNB, I_CQG, I_UQW, I_CKVG, I_UKVW, I_QNG, I_QRG, I_KNG, I_KRG, I_POOLW, I_POOLS, N_IN };

constexpr size_t MiB = 1u << 20;
constexpr size_t WS_CTL = 0, CTL_ZERO_BYTES = 64 * 1024;
constexpr size_t WS_MOD = 1 * MiB;
constexpr size_t WS_RS = WS_MOD + 512 * 1024;
constexpr size_t WS_WINT = 2 * MiB;
constexpr size_t WS_WOUTT = WS_WINT + (size_t)2 * 2560 * 1024 * 2;
constexpr size_t WS_W13T = WS_WOUTT + (size_t)2 * 1024 * 1024 * 2;
constexpr size_t WS_W2T = WS_W13T + (size_t)4 * 5632 * 1024 * 2;
constexpr size_t WS_WUQT = WS_W2T + (size_t)4 * 1024 * 2816 * 2;
constexpr size_t WS_WUKVT = WS_WUQT + (size_t)2 * 768 * 384 * 2;
constexpr size_t WS_POOLT = WS_WUKVT + (size_t)2 * 1024 * 256 * 2;
constexpr size_t WS_WLORAT = WS_POOLT + (size_t)2 * 1024 * 256 * 2;
constexpr size_t WS_XN = WS_WLORAT + (size_t)2 * 2560 * 256 * 2;
constexpr size_t WS_BIG = WS_XN + (size_t)NT * 1024 * 2;
constexpr size_t WS_RB = WS_BIG + (size_t)NT * 2816 * 2;
constexpr size_t WS_KB = WS_RB + (size_t)NT * 512 * 2;
constexpr size_t WS_VB = WS_KB + (size_t)NT * 512 * 2;
constexpr size_t WS_KKB = WS_VB + (size_t)NT * 512 * 2;
constexpr size_t WS_L = WS_KKB + (size_t)NT * 512 * 2;
constexpr size_t WS_CQ = WS_L + (size_t)NT * 256 * 2;
constexpr size_t WS_CKV = WS_CQ + (size_t)NT * 384 * 2;
constexpr size_t WS_KRB = WS_CKV + (size_t)NKV * 256 * 2;
constexpr size_t WS_QRAW = WS_KRB + (size_t)NKV * 64 * 2;
constexpr size_t WS_KVRAW = WS_QRAW + (size_t)NT * 768 * 2;
constexpr size_t WS_QF = WS_KVRAW + (size_t)NKV * 1024 * 2;
constexpr size_t WS_KF = WS_QF + (size_t)NT * 768 * 2;
constexpr size_t WS_Y0 = WS_KF + (size_t)NKV * 512 * 2;
constexpr size_t WS_END = WS_Y0 + (size_t)2 * NT * 512 * 4;
constexpr size_t WS_SCR_AB = WS_QRAW;
constexpr size_t WS_SCR_ACC = WS_L;
static_assert((size_t)1024 * 18432 <= (size_t)NT * 768 * 2 && WS_SCR_ACC + (size_t)1024 * 16384 <= WS_KRB, "scan scratch");
static_assert(WS_WINT % 256 == 0 && WS_XN % 256 == 0 && WS_BIG % 256 == 0 && WS_Y0 % 256 == 0, "alignment");

constexpr int RING_BYTES = 131072, LDSCTL_OFF = RING_BYTES, MISC_OFF = LDSCTL_OFF + 320, LDS_BYTES = 147456;
constexpr int NWAVES = 8, NTHR = 512;

typedef unsigned short bf16_t;
typedef float f32x4 __attribute__((ext_vector_type(4)));
typedef float f32x16 __attribute__((ext_vector_type(16)));
typedef short bf16x8 __attribute__((ext_vector_type(8)));
typedef unsigned u32x4 __attribute__((ext_vector_type(4)));
typedef unsigned u32x2 __attribute__((ext_vector_type(2)));

DI float bf2f(unsigned b) { return __uint_as_float(b << 16); }
DI unsigned pk2(float lo, float hi) { typedef float f2 __attribute__((ext_vector_type(2))); typedef __bf16 b2 __attribute__((ext_vector_type(2))); f2 v = {lo, hi}; b2 b = __builtin_convertvector(v, b2); return __builtin_bit_cast(unsigned, b); }
DI void unpack8(const u32x4 v, float* f) { f[0] = bf2f(v.x & 0xffffu); f[1] = __uint_as_float(v.x & 0xffff0000u); f[2] = bf2f(v.y & 0xffffu); f[3] = __uint_as_float(v.y & 0xffff0000u);
                                           f[4] = bf2f(v.z & 0xffffu); f[5] = __uint_as_float(v.z & 0xffff0000u); f[6] = bf2f(v.w & 0xffffu); f[7] = __uint_as_float(v.w & 0xffff0000u); }
DI u32x4 pack8(const float* f) { u32x4 o; o.x = pk2(f[0], f[1]); o.y = pk2(f[2], f[3]); o.z = pk2(f[4], f[5]); o.w = pk2(f[6], f[7]); return o; }
DI float sigm(float x) { return 1.f / (1.f + __expf(-x)); }
DI float siluf(float x) { return x / (1.f + __expf(-x)); }
DI float wave_sum(float v) {
#pragma unroll
    for (int o = 1; o < 64; o <<= 1) v += __shfl_xor(v, o);
    return v;
}
DI int lane_id_volatile() { int l; asm volatile("v_mbcnt_lo_u32_b32 %0, -1, 0\n\tv_mbcnt_hi_u32_b32 %0, -1, %0" : "=v"(l)); return l; }
DI int mod_set(int row) { return row < NCTX ? 0 : 1 + ((row - NCTX) >> 11); }
#define ONE_LAUNCH 1
namespace pg8 {
#define PG8_LAS __attribute__((address_space(3)))
typedef unsigned short bf16_t;
typedef short bf16x8 __attribute__((ext_vector_type(8)));
typedef float f32x4 __attribute__((ext_vector_type(4)));
typedef unsigned u32x4 __attribute__((ext_vector_type(4)));
constexpr int BM = 256, BK = 64, HALF = 128, HTB = HALF * BK * 2  , STAGE_BYTES = 8 * HTB, NXCD = 8, WGM = 8;

__host__ __device__ __forceinline__ int lds_byte(int r, int c) { const int st = (r >> 4) * 2 + (c >> 5), rr = r & 15, cc = c & 31, ob = rr * 64 + cc * 2; return st * 1024 + (ob ^ (((ob >> 9) & 1) << 5)); }
__host__ __device__ __forceinline__ void stage_rc(int b, int& R, int& C) { const int st = b / 1024, sb = b % 1024, swz = sb ^ (((sb >> 9) & 1) << 5); R = (st >> 1) * 16 + swz / 64; C = (st & 1) * 32 + (swz % 64) / 2; }
__host__ __device__ __forceinline__ int perm32(int rho) { const int n = rho >> 4, i = rho & 15; return 8 * (i >> 2) + 4 * n + (i & 3); }

struct Unit { int pm, pn; };
struct Gemm { const bf16_t* A; const bf16_t* Bt; int M, N, K, lda, a_pn_off; };

struct StaticOrder {
    int nM, nN, nwg, G, c;
    __host__ __device__ void init(int M, int N, int G_, int c_) { nM = M / BM; nN = N / BM; nwg = nM * nN; G = G_; c = c_; }
    __host__ __device__ bool next(int i, Unit& u) const {
        const long L = (long)i * G + c; if (L >= nwg) return false;
        int wgid = (int)L; { const int q = nwg / NXCD, r = nwg % NXCD, xcd = wgid % NXCD, off = wgid / NXCD; wgid = (xcd < r ? xcd * (q + 1) : r * (q + 1) + (xcd - r) * q) + off; }
        const int nig = WGM * nN, gid = wgid / nig, fm = gid * WGM, gsz = (nM - fm) < WGM ? (nM - fm) : WGM;
        u.pm = fm + ((wgid % nig) % gsz); u.pn = (wgid % nig) / gsz; return true;
    }
    __device__ __forceinline__ void a_ready(const Unit&) const {}
    __device__ __forceinline__ void done(const Unit&) const {}
};


__device__ __forceinline__ unsigned cvt_pk_bf16(float lo, float hi) { typedef float f2 __attribute__((ext_vector_type(2))); typedef __bf16 b2 __attribute__((ext_vector_type(2))); f2 v = {lo, hi}; b2 b = __builtin_convertvector(v, b2); return __builtin_bit_cast(unsigned, b); }
__device__ __forceinline__ float sigm_(float x) { return 1.f / (1.f + __expf(-x)); }

struct EpiBf16 {
    static constexpr bool PERM = true, AFTER_DRAIN = false;
    bf16_t* O; int ldc; int lora; const float* w0; const float* a0;
    __device__ __forceinline__ void operator()(const f32x4 (&acc)[2][2][4][2], const Unit& u, int wr, int wc, int fr, int fq) const {
        const int row0 = u.pm * BM + wr * 64 + fr, col0 = u.pn * BM + wc * 32 + 8 * fq;
        const int seg = lora ? (u.pn >> 1) : 4;
        f32x4 bv[2][2];
#pragma unroll
        for (int bj = 0; bj < 2; ++bj)
#pragma unroll
            for (int n = 0; n < 2; ++n) {
                bv[bj][n] = (f32x4){0.f, 0.f, 0.f, 0.f};
                if (seg < 4) { const int cc = (col0 + bj * HALF + 4 * n) & 511; const float* bp = (seg < 2) ? (w0 + seg * 512 + cc) : (a0 + (seg - 2) * 512 + cc); bv[bj][n] = *(const f32x4*)bp; }
            }
        const float mul = (seg < 2) ? 0.6065306597126334f : 1.0f;
#pragma unroll
        for (int ai = 0; ai < 2; ++ai)
#pragma unroll
            for (int m = 0; m < 4; ++m) { bf16_t* rowp = O + (size_t)(row0 + ai * HALF + m * 16) * ldc + col0;
#pragma unroll
                for (int bj = 0; bj < 2; ++bj) { f32x4 v0 = acc[ai][bj][m][0], v1 = acc[ai][bj][m][1];
                    if (seg < 4) { v0 = v0 + bv[bj][0]; v1 = v1 + bv[bj][1];
#pragma unroll
                        for (int e = 0; e < 4; ++e) { v0[e] = mul * sigm_(v0[e]); v1[e] = mul * sigm_(v1[e]); } }
                    u32x4 w; w.x = cvt_pk_bf16(v0[0], v0[1]); w.y = cvt_pk_bf16(v0[2], v0[3]); w.z = cvt_pk_bf16(v1[0], v1[1]); w.w = cvt_pk_bf16(v1[2], v1[3]);
                    *(u32x4*)(rowp + bj * HALF) = w; } }
    }
};
struct EpiSwiglu {
    static constexpr bool PERM = true, AFTER_DRAIN = false;
    bf16_t* O; int ldc;
    __device__ __forceinline__ void operator()(const f32x4 (&acc)[2][2][4][2], const Unit& u, int wr, int wc, int fr, int fq) const {
        const int row0 = u.pm * BM + wr * 64 + fr, col0 = u.pn * HALF + wc * 32 + 8 * fq;
#pragma unroll
        for (int ai = 0; ai < 2; ++ai)
#pragma unroll
            for (int m = 0; m < 4; ++m) { bf16_t* rowp = O + (size_t)(row0 + ai * HALF + m * 16) * ldc + col0;
                f32x4 h0, h1;
#pragma unroll
                for (int e = 0; e < 4; ++e) { const float a0_ = acc[ai][0][m][0][e], a1_ = acc[ai][0][m][1][e];
                    h0[e] = a0_ * sigm_(a0_) * acc[ai][1][m][0][e]; h1[e] = a1_ * sigm_(a1_) * acc[ai][1][m][1][e]; }
                u32x4 w; w.x = cvt_pk_bf16(h0[0], h0[1]); w.y = cvt_pk_bf16(h0[2], h0[3]); w.z = cvt_pk_bf16(h1[0], h1[1]); w.w = cvt_pk_bf16(h1[2], h1[3]);
                *(u32x4*)rowp = w; }
    }
};
struct EpiResid {
    static constexpr bool PERM = false, AFTER_DRAIN = false;
    const float* Yin; float* Yout; int ldc; const float* gate; const float* colscale;
    __device__ __forceinline__ void operator()(const f32x4 (&acc)[2][2][4][2], const Unit& u, int wr, int wc, int fr, int fq) const {
        const int set = u.pm < 32 ? 0 : 1 + ((u.pm - 32) >> 3);
        const float* gp = gate + set * 6144;
        const int col0 = u.pn * BM + wc * 32 + 4 * fq;
#pragma unroll
        for (int bj = 0; bj < 2; ++bj)
#pragma unroll
            for (int n = 0; n < 2; ++n) { const int c = col0 + bj * HALF + n * 16;
                f32x4 gv = *(const f32x4*)(gp + c); if (colscale) gv = gv * *(const f32x4*)(colscale + c);
#pragma unroll
                for (int ai = 0; ai < 2; ++ai)
#pragma unroll
                    for (int m = 0; m < 4; ++m) { const size_t off = (size_t)(u.pm * BM + ai * HALF + wr * 64 + m * 16 + fr) * ldc + c;
                        const f32x4 bs = *(const f32x4*)(Yin + off); *(f32x4*)(Yout + off) = bs + gv * acc[ai][bj][m][n]; } }
    }
};

template <class Epi, class Sched, bool ALIGN_EPI = false, bool SP2 = false>
__device__ __forceinline__ void gemm_phase(PG8_LAS unsigned char* lds, const Gemm g, const Sched& S, const Epi& E, const int tid) {
    const int wid = __builtin_amdgcn_readfirstlane(tid >> 6), lane = tid & 63, wr = wid >> 2, wc = wid & 3, fr = lane & 15, fq = lane >> 4;
    const int K = g.K, nt = K / BK;
    unsigned voffA[2], voffB[2];
#pragma unroll
    for (int i = 0; i < 2; ++i) { int R, C; stage_rc(tid * 16 + i * 8192, R, C); const int Rb = Epi::PERM ? ((R & ~31) + perm32(R & 31)) : R;
        voffA[i] = (unsigned)(R * g.lda + C) * 2u; voffB[i] = (unsigned)(Rb * K + C) * 2u; }
    const size_t kstep = (size_t)(BK * 2);
    const size_t hstepA = (size_t)HALF * g.lda * 2, hstepB = (size_t)HALF * K * 2;
    const size_t tstepA = 2 * hstepA, tstepB = 2 * hstepB;
    const size_t apn = (size_t)g.a_pn_off * 2;
    const unsigned ldsw = (unsigned)wid * 1024u;
    const int aoff = lds_byte(wr * 64 + fr, fq * 8), boff = lds_byte(wc * 32 + fr, fq * 8);
#define PG8_SA(b, h) (((b) * 2 + (h)) * HTB)
#define PG8_SB(b, h) ((4 + (b) * 2 + (h)) * HTB)
#define PG8_STAGE(bufoff, gbase, voff) do { _Pragma("unroll") for (int _i = 0; _i < 2; ++_i) \
        __builtin_amdgcn_global_load_lds((const unsigned*)((const char*)(gbase) + (voff)[_i]), (PG8_LAS unsigned*)(lds + (bufoff) + ldsw + _i * 8192), 16, 0, 0); } while (0)
#define PG8_LDA(dst, b, h) do { _Pragma("unroll") for (int m = 0; m < 4; ++m) _Pragma("unroll") for (int k = 0; k < 2; ++k) dst[m][k] = *(const PG8_LAS bf16x8*)(lds + PG8_SA(b, h) + aoff + m * 2048 + k * 1024); } while (0)
#define PG8_LDB(dst, b, h) do { _Pragma("unroll") for (int n = 0; n < 2; ++n) _Pragma("unroll") for (int k = 0; k < 2; ++k) dst[n][k] = *(const PG8_LAS bf16x8*)(lds + PG8_SB(b, h) + boff + n * 2048 + k * 1024); } while (0)
#define PG8_MMA(ai, bj, At, Bt) do { __builtin_amdgcn_s_setprio(1); _Pragma("unroll") for (int m = 0; m < 4; ++m) _Pragma("unroll") for (int n = 0; n < 2; ++n) _Pragma("unroll") for (int k = 0; k < 2; ++k) \
        acc[ai][bj][m][n] = __builtin_amdgcn_mfma_f32_16x16x32_bf16(Bt[n][k], At[m][k], acc[ai][bj][m][n], 0, 0, 0); __builtin_amdgcn_s_setprio(0); } while (0)
#define PG8_WAIT_V(n) asm volatile("s_waitcnt vmcnt(" #n ")" ::: "memory")
#define PG8_WAIT_L(n) asm volatile("s_waitcnt lgkmcnt(" #n ")" ::: "memory")
#define PG8_BAR __builtin_amdgcn_s_barrier()
#define PG8_SCHED __builtin_amdgcn_sched_barrier(0)
    Unit cur, nxt; int ui = 0;
    if (!S.next(0, cur)) return;
    f32x4 acc[2][2][4][2];
#pragma unroll
    for (int a = 0; a < 2; ++a)
#pragma unroll
        for (int b = 0; b < 2; ++b)
#pragma unroll
            for (int m = 0; m < 4; ++m)
#pragma unroll
                for (int n = 0; n < 2; ++n) acc[a][b][m][n] = (f32x4){0.f, 0.f, 0.f, 0.f};
    bf16x8 At[4][2], B0[2][2], B1[2][2];
    const char* cA = (const char*)g.A + (size_t)cur.pm * tstepA + (size_t)cur.pn * apn; const char* cB = (const char*)g.Bt + (size_t)cur.pn * tstepB;
    S.a_ready(cur);
    if constexpr (SP2) {
        PG8_STAGE(PG8_SB(0, 0), cB, voffB); PG8_STAGE(PG8_SB(0, 1), cB + hstepB, voffB); PG8_STAGE(PG8_SA(0, 0), cA, voffA); PG8_STAGE(PG8_SA(0, 1), cA + hstepA, voffA);
        if (wr == 1) PG8_BAR;
        PG8_WAIT_V(2); PG8_BAR;
        PG8_STAGE(PG8_SB(1, 0), cB + kstep, voffB); PG8_STAGE(PG8_SA(1, 0), cA + kstep, voffA); PG8_STAGE(PG8_SB(1, 1), cB + hstepB + kstep, voffB);
        PG8_WAIT_V(6); PG8_BAR;
    } else {
        PG8_STAGE(PG8_SB(0, 0), cB, voffB); PG8_STAGE(PG8_SA(0, 0), cA, voffA); PG8_STAGE(PG8_SB(0, 1), cB + hstepB, voffB); PG8_STAGE(PG8_SA(0, 1), cA + hstepA, voffA);
        if (wr == 1) PG8_BAR;
        PG8_WAIT_V(4); PG8_BAR;
        PG8_STAGE(PG8_SB(1, 0), cB + kstep, voffB); PG8_STAGE(PG8_SA(1, 0), cA + kstep, voffA); PG8_STAGE(PG8_SB(1, 1), cB + hstepB + kstep, voffB);
        PG8_WAIT_V(6); PG8_BAR;
    }
    for (;;) {
        const bool has_next = S.next(ui + 1, nxt);
        const char* nA = has_next ? (const char*)g.A + (size_t)nxt.pm * tstepA + (size_t)nxt.pn * apn : cA; const char* nB = has_next ? (const char*)g.Bt + (size_t)nxt.pn * tstepB : cB;
        for (int t = 0; t < nt; t += 2) {
            const bool last = (t == nt - 2);
            const char* a1 = cA + (size_t)(t + 1) * kstep;
            const char* a2 = last ? nA : cA + (size_t)(t + 2) * kstep; const char* b2 = last ? nB : cB + (size_t)(t + 2) * kstep;
            const char* a3 = a2 + kstep; const char* b3 = b2 + kstep;
            if (last && has_next) S.a_ready(nxt);
            if constexpr (SP2) {
            PG8_LDB(B0, 0, 0); PG8_LDB(B1, 0, 1); PG8_SCHED; PG8_LDA(At, 0, 0); PG8_STAGE(PG8_SA(1, 1), a1 + hstepA, voffA);
            PG8_WAIT_V(8); PG8_WAIT_L(0); PG8_BAR; PG8_MMA(0, 0, At, B0); PG8_MMA(0, 1, At, B1); PG8_BAR; PG8_SCHED;
            PG8_LDA(At, 0, 1); PG8_STAGE(PG8_SB(0, 0), b2, voffB); PG8_STAGE(PG8_SB(0, 1), b2 + hstepB, voffB); PG8_STAGE(PG8_SA(0, 0), a2, voffA);
            PG8_WAIT_V(8); PG8_WAIT_L(0); PG8_BAR; PG8_MMA(1, 0, At, B0); PG8_MMA(1, 1, At, B1); PG8_BAR; PG8_SCHED;
            PG8_LDB(B0, 1, 0); PG8_LDB(B1, 1, 1); PG8_SCHED; PG8_LDA(At, 1, 0); PG8_STAGE(PG8_SA(0, 1), a2 + hstepA, voffA);
            PG8_WAIT_V(8); PG8_WAIT_L(0); PG8_BAR; PG8_MMA(0, 0, At, B0); PG8_MMA(0, 1, At, B1); PG8_BAR; PG8_SCHED;
            PG8_LDA(At, 1, 1); PG8_STAGE(PG8_SB(1, 0), b3, voffB); PG8_STAGE(PG8_SB(1, 1), b3 + hstepB, voffB); PG8_STAGE(PG8_SA(1, 0), a3, voffA);
            PG8_WAIT_V(8); PG8_WAIT_L(0); PG8_BAR; PG8_MMA(1, 0, At, B0); PG8_MMA(1, 1, At, B1); PG8_BAR; PG8_SCHED;
            } else {
            PG8_LDB(B0, 0, 0); PG8_SCHED; PG8_LDA(At, 0, 0); PG8_STAGE(PG8_SA(1, 1), a1 + hstepA, voffA);
            PG8_WAIT_L(8); PG8_BAR; PG8_WAIT_L(0); PG8_MMA(0, 0, At, B0); PG8_BAR; PG8_SCHED;
            PG8_LDB(B1, 0, 1); PG8_STAGE(PG8_SB(0, 0), b2, voffB);
            PG8_BAR; PG8_WAIT_L(0); PG8_MMA(0, 1, At, B1); PG8_BAR;
            PG8_LDA(At, 0, 1); PG8_STAGE(PG8_SA(0, 0), a2, voffA);
            PG8_BAR; PG8_WAIT_L(0); PG8_MMA(1, 0, At, B0); PG8_BAR; PG8_SCHED;
            PG8_STAGE(PG8_SB(0, 1), b2 + hstepB, voffB);
            PG8_WAIT_V(6); PG8_BAR; PG8_MMA(1, 1, At, B1); PG8_BAR;
            PG8_LDB(B0, 1, 0); PG8_SCHED; PG8_LDA(At, 1, 0); PG8_STAGE(PG8_SA(0, 1), a2 + hstepA, voffA);
            PG8_WAIT_L(8); PG8_BAR; PG8_WAIT_L(0); PG8_MMA(0, 0, At, B0); PG8_BAR; PG8_SCHED;
            PG8_LDB(B1, 1, 1); PG8_STAGE(PG8_SB(1, 0), b3, voffB);
            PG8_BAR; PG8_WAIT_L(0); PG8_MMA(0, 1, At, B1); PG8_BAR;
            PG8_LDA(At, 1, 1); PG8_STAGE(PG8_SA(1, 0), a3, voffA);
            PG8_BAR; PG8_WAIT_L(0); PG8_MMA(1, 0, At, B0); PG8_BAR; PG8_SCHED;
            PG8_STAGE(PG8_SB(1, 1), b3 + hstepB, voffB);
            PG8_WAIT_V(6); PG8_BAR; PG8_MMA(1, 1, At, B1); PG8_BAR;
            }
        }
        if constexpr (ALIGN_EPI) { if (wr == 0) PG8_BAR; }
        if constexpr (!Epi::AFTER_DRAIN) { E(acc, cur, wr, wc, fr, fq); S.done(cur); }
        if (!has_next) break;
#pragma unroll
        for (int a = 0; a < 2; ++a)
#pragma unroll
            for (int b = 0; b < 2; ++b)
#pragma unroll
                for (int m = 0; m < 4; ++m)
#pragma unroll
                    for (int n = 0; n < 2; ++n) acc[a][b][m][n] = (f32x4){0.f, 0.f, 0.f, 0.f};
        cur = nxt; cA = nA; cB = nB; ++ui;
        if constexpr (ALIGN_EPI) { if (wr == 1) PG8_BAR; }
    }
    PG8_WAIT_V(0);
    if constexpr (!ALIGN_EPI) { if (wr == 0) PG8_BAR; }
    PG8_BAR;
    if constexpr (Epi::AFTER_DRAIN) { E.fused(acc, cur, wr, wc, fr, fq, lds, wid, lane); S.done(cur); }
#undef PG8_SA
#undef PG8_SB
#undef PG8_STAGE
#undef PG8_LDA
#undef PG8_LDB
#undef PG8_MMA
#undef PG8_WAIT_V
#undef PG8_WAIT_L
#undef PG8_BAR
#undef PG8_SCHED
}
}
#define XB_TMO      128
#define XB_XCNT(j)  (256  + 64 * (j))
#define XB_XSUB(j)  (1280 + 64 * (j))
#define XB_XGEN(j)  (2304 + 64 * (j))
#define XB_TOP      3328
#define XB_TOPGEN   3392
#define XCD_BAR_WORDS 3456
#define XB_SPIN_CAP (1u << 18)

__device__ __forceinline__ unsigned xb_ld(unsigned* p)              { return __hip_atomic_load(p, __ATOMIC_RELAXED, __HIP_MEMORY_SCOPE_AGENT); }
__device__ __forceinline__ unsigned xb_add(unsigned* p, unsigned v) { return __hip_atomic_fetch_add(p, v, __ATOMIC_RELAXED, __HIP_MEMORY_SCOPE_AGENT); }
__device__ __forceinline__ unsigned xb_xcc_id() { return (unsigned)__builtin_amdgcn_s_getreg((3 << 11) | 20) & 0xFu; }
#define XB_SPIN(cond, bar) do { unsigned _sp = 0; while (cond) { __builtin_amdgcn_s_sleep(1); \
    if ((++_sp & 255u) == 0u) { if (xb_ld(&(bar)[XB_TMO])) break; if (_sp > XB_SPIN_CAP) { atomicAdd(&(bar)[XB_TMO], 1u); break; } } } } while (0)

struct XcdBarrier {
    unsigned* bar; unsigned x;
    volatile LAS unsigned* st;
};

__device__ __forceinline__ XcdBarrier xcd_barrier_post(unsigned* bar, volatile LAS unsigned* st) {
    XcdBarrier b; b.bar = bar; b.x = xb_xcc_id(); b.st = st;
    if (threadIdx.x == 0) (void)xb_add(&bar[XB_XCNT(b.x)], 1u);
    return b;
}
__device__ __forceinline__ void xcd_barrier_complete(unsigned* bar, unsigned x, unsigned& nloc, unsigned& nx) {
    const unsigned G = gridDim.x * gridDim.y * gridDim.z;
    unsigned sum, cnt, mine, sp = 0u;
    for (;;) {
        sum = 0u; cnt = 0u; mine = 0u;
#pragma unroll
        for (unsigned j = 0; j < 16; ++j) { const unsigned c = xb_ld(&bar[XB_XCNT(j)]); sum += c; cnt += (c > 0u) ? 1u : 0u; mine = (j == x) ? c : mine; }
        if (sum == G) break;
        __builtin_amdgcn_s_sleep(1);
        if ((++sp & 255u) == 0u) { if (xb_ld(&bar[XB_TMO])) break; if (sp > XB_SPIN_CAP) { atomicAdd(&bar[XB_TMO], 1u); break; } }
    }
    nloc = mine > 0u ? mine : 1u; nx = cnt > 0u ? cnt : 1u;
}

__device__ __forceinline__ void xcd_barrier(const XcdBarrier& b, const bool leader_thread) {
    asm volatile("s_waitcnt vmcnt(0)" ::: "memory");
    __syncthreads();
    if (leader_thread) {
        unsigned* bar = b.bar;
        __builtin_amdgcn_s_waitcnt(0);
        unsigned nloc = b.st[0], nx = b.st[1];
        if (nloc == 0u) { xcd_barrier_complete(bar, b.x, nloc, nx); b.st[0] = nloc; b.st[1] = nx; }
        const unsigned old = xb_add(&bar[XB_XSUB(b.x)], 1u);
        const unsigned gen = old / nloc;
        if (old + 1u == (gen + 1u) * nloc) {
            __builtin_amdgcn_fence(__ATOMIC_RELEASE, "agent");
            asm volatile("s_waitcnt vmcnt(0)" ::: "memory");
            const unsigned og = xb_add(&bar[XB_TOP], 1u);
            const unsigned tg = og / nx;
            if (og + 1u == (tg + 1u) * nx) xb_add(&bar[XB_TOPGEN], 1u);
            else XB_SPIN(xb_ld(&bar[XB_TOPGEN]) == tg, bar);
            __builtin_amdgcn_fence(__ATOMIC_ACQUIRE, "agent");
            xb_add(&bar[XB_XGEN(b.x)], 1u);
            asm volatile("s_waitcnt vmcnt(0)" ::: "memory");
        } else {
            XB_SPIN(xb_ld(&bar[XB_XGEN(b.x)]) == gen, bar);
            __builtin_amdgcn_fence(__ATOMIC_ACQUIRE, "agent");
            asm volatile("s_waitcnt vmcnt(0)" ::: "memory");
        }
    }
    __syncthreads();
}

struct Args { const float* in[N_IN]; float* out; unsigned char* ws; int ph_lo, ph_hi, use_bar, pad; };
typedef const float* cfp_t;
typedef const __attribute__((address_space(4))) cfp_t* KIn;
struct P { KIn in; float* out; unsigned char* ws; };

#define LDS_WAIT() asm volatile("s_waitcnt lgkmcnt(0)" ::: "memory")

DI void transpose_item(const float* src, int src_ld, int k0, int n0, bf16_t* dst, int dst_ld, int dst_row0, int dst_col0, LAS float* scr, int lane) {
#pragma unroll 8
    for (int i = 0; i < 32; ++i) { const int kk = 2 * i + (lane >> 5); scr[kk * 33 + (lane & 31)] = src[(size_t)(k0 + kk) * src_ld + n0 + (lane & 31)]; }
    LDS_WAIT(); asm volatile("" ::: "memory");
    const int c = lane & 7;
#pragma unroll
    for (int j = 0; j < 4; ++j) { const int n = (lane >> 3) + 8 * j; const LAS float* s = scr + (8 * c) * 33 + n;
        u32x4 o; o.x = pk2(s[0 * 33], s[1 * 33]); o.y = pk2(s[2 * 33], s[3 * 33]); o.z = pk2(s[4 * 33], s[5 * 33]); o.w = pk2(s[6 * 33], s[7 * 33]);
        *(u32x4*)(dst + (size_t)(dst_row0 + n) * dst_ld + dst_col0 + 8 * c) = o; }
    LDS_WAIT(); asm volatile("" ::: "memory");
}
DI void zero_item(bf16_t* dst, int dst_ld, int dst_row0, int dst_col0, int lane) {
#pragma unroll
    for (int j = 0; j < 4; ++j) { const int n = (lane >> 3) + 8 * j; *(u32x4*)(dst + (size_t)(dst_row0 + n) * dst_ld + dst_col0 + 8 * (lane & 7)) = (u32x4){0u, 0u, 0u, 0u}; }
}

DI void phase_p0(const P& a, LAS unsigned char* lds, int tid, int lane, int wave, int G, int bid) {
    unsigned char* ws = a.ws;
    {
        LAS float* red = (LAS float*)lds;
        float* MOD = (float*)(ws + WS_MOD);
        const float* adaw = a.in[I_ADAW]; const float* adab = a.in[I_ADAB]; const float* cctx = a.in[I_CCTX]; const float* cc = a.in[I_C];
        for (int u = bid; u < 4 * 96; u += G) {
            const int l = u / 96, n = (u % 96) * 64 + lane;
            const float* W = adaw + (size_t)l * 1024 * 6144 + n;
            const int k0 = wave * 128;
            float s0 = 0.f, s1 = 0.f, s2 = 0.f;
#pragma unroll 8
            for (int kk = 0; kk < 128; ++kk) { const int k = k0 + kk; const float w = W[(size_t)k * 6144];
                s0 += siluf(cctx[k]) * w; s1 += siluf(cc[k]) * w; s2 += siluf(cc[1024 + k]) * w; }
            red[(wave * 3 + 0) * 64 + lane] = s0; red[(wave * 3 + 1) * 64 + lane] = s1; red[(wave * 3 + 2) * 64 + lane] = s2;
            __syncthreads();
            if (tid < 192) { const int s = tid >> 6, ln = tid & 63; float t = 0.f;
#pragma unroll
                for (int w8 = 0; w8 < 8; ++w8) t += red[(w8 * 3 + s) * 64 + ln];
                const int nn = (u % 96) * 64 + ln;
                MOD[(size_t)(l * 3 + s) * 6144 + nn] = t + adab[l * 6144 + nn]; }
            __syncthreads();
        }
    }
    {
        const f32x4* xp = (const f32x4*)a.in[I_XP]; const f32x4* xs = (const f32x4*)a.in[I_XS]; f32x4* y = (f32x4*)(a.out + OUT_Y);
        const int n4p = NCTX * 256, n4 = NT * 256;
        for (int i = bid * NTHR + tid; i < n4; i += G * NTHR) y[i] = (i < n4p) ? xp[i] : xs[i - n4p];
    }
    {
        LAS float* scr = (LAS float*)(lds + 8192 + wave * 8448);
        const int gw = bid * NWAVES + wave, NGW = G * NWAVES;
        constexpr int C_IN = 16 * 78, C_OUT = 16 * 32, C_W1 = 16 * 88, C_W2 = 44 * 32, C_UQ = 6 * 24, C_UKV = 4 * 32, C_POOL = 4 * 8, C_LORA = 320, C_ZP = 32;
        constexpr int NITEMS = 2 * C_IN + 2 * C_OUT + 8 * C_W1 + 4 * C_W2 + 2 * C_UQ + 2 * C_UKV + 8 * C_POOL + 2 * C_LORA + 2 * C_ZP;
        for (int it = gw; it < NITEMS; it += NGW) {
            int r = it;
            if (r < 2 * C_IN) { const int i = r / C_IN; r %= C_IN; const int kb = r / 78, nb = r % 78;
                transpose_item(a.in[I_INW] + (size_t)i * 1024 * IN_DIM, IN_DIM, 64 * kb, 32 * nb, (bf16_t*)(ws + WS_WINT) + (size_t)i * IN_PAD * 1024, 1024, 32 * nb, 64 * kb, scr, lane); continue; }
            r -= 2 * C_IN;
            if (r < 2 * C_OUT) { const int i = r / C_OUT; r %= C_OUT; const int kb = r / 32, nb = r % 32;
                transpose_item(a.in[I_OUTW] + (size_t)i * 1024 * 1024, 1024, 64 * kb, 32 * nb, (bf16_t*)(ws + WS_WOUTT) + (size_t)i * 1024 * 1024, 1024, 32 * nb, 64 * kb, scr, lane); continue; }
            r -= 2 * C_OUT;
            if (r < 8 * C_W1) { const int lw = r / C_W1; r %= C_W1; const int l = lw >> 1, which = lw & 1; const int kb = r / 88, nb = r % 88; const int n0 = 32 * nb;
                const float* src = (which ? a.in[I_W3] : a.in[I_W1]) + (size_t)l * 1024 * DFF;
                transpose_item(src, DFF, 64 * kb, n0, (bf16_t*)(ws + WS_W13T) + (size_t)l * 5632 * 1024, 1024, (n0 >> 7) * 256 + which * 128 + (n0 & 127), 64 * kb, scr, lane); continue; }
            r -= 8 * C_W1;
            if (r < 4 * C_W2) { const int l = r / C_W2; r %= C_W2; const int kb = r / 32, nb = r % 32;
                transpose_item(a.in[I_W2] + (size_t)l * DFF * 1024, 1024, 64 * kb, 32 * nb, (bf16_t*)(ws + WS_W2T) + (size_t)l * 1024 * DFF, DFF, 32 * nb, 64 * kb, scr, lane); continue; }
            r -= 4 * C_W2;
            if (r < 2 * C_UQ) { const int i = r / C_UQ; r %= C_UQ; const int kb = r / 24, nb = r % 24;
                transpose_item(a.in[I_UQW] + (size_t)i * 384 * 768, 768, 64 * kb, 32 * nb, (bf16_t*)(ws + WS_WUQT) + (size_t)i * 768 * 384, 384, 32 * nb, 64 * kb, scr, lane); continue; }
            r -= 2 * C_UQ;
            if (r < 2 * C_UKV) { const int i = r / C_UKV; r %= C_UKV; const int kb = r / 32, nb = r % 32;
                transpose_item(a.in[I_UKVW] + (size_t)i * 256 * 1024, 1024, 64 * kb, 32 * nb, (bf16_t*)(ws + WS_WUKVT) + (size_t)i * 1024 * 256, 256, 32 * nb, 64 * kb, scr, lane); continue; }
            r -= 2 * C_UKV;
            if (r < 8 * C_POOL) { const int jg = r / C_POOL; r %= C_POOL; const int j = jg >> 2, g = jg & 3; const int kb = r / 8, nb = r % 8;
                transpose_item(a.in[I_POOLW] + (size_t)jg * 256 * 256, 256, 64 * kb, 32 * nb, (bf16_t*)(ws + WS_POOLT) + (size_t)j * 1024 * 256, 256, g * 256 + 32 * nb, 64 * kb, scr, lane); continue; }
            r -= 8 * C_POOL;
            if (r < 2 * C_LORA) { const int i = r / C_LORA; r %= C_LORA; const int rb = r >> 2, cb = r & 3; const int seg = rb >> 4, n0 = (rb & 15) * 32;
                bf16_t* dst = (bf16_t*)(ws + WS_WLORAT) + (size_t)i * IN_PAD * 256;
                if (seg < 2 && cb == 0) transpose_item(a.in[I_WUP] + (size_t)(i * 2 + seg) * 64 * 512, 512, 0, n0, dst, 256, rb * 32, 0, scr, lane);
                else if (seg >= 2 && seg < 4 && cb == 1) transpose_item(a.in[I_AUP] + (size_t)(i * 2 + seg - 2) * 64 * 512, 512, 0, n0, dst, 256, rb * 32, 64, scr, lane);
                else if (seg == 4 && cb >= 2) transpose_item(a.in[I_GUP] + (size_t)i * 128 * 512, 512, (cb - 2) * 64, n0, dst, 256, rb * 32, cb * 64, scr, lane);
                else zero_item(dst, 256, rb * 32, cb * 64, lane);
                continue; }
            r -= 2 * C_LORA;
            { const int i = r / C_ZP; r %= C_ZP; const int rb = r >> 4, cb = r & 15;
              zero_item((bf16_t*)(ws + WS_WINT) + (size_t)i * IN_PAD * 1024, 1024, IN_DIM + rb * 32, cb * 64, lane); }
        }
    }
}

DI void phase_norm(const float* Y, const float* gvec, const float* modl, int shift_idx, int scale_idx, bf16_t* XN, float* RS, int mode, int lane, int wave, int G, int bid) {
    const int gw = bid * NWAVES + wave, NGW = G * NWAVES;
    for (int row = gw; row < NT; row += NGW) {
        const f32x4* xr = (const f32x4*)(Y + (size_t)row * D) + lane;
        f32x4 v[4]; float s = 0.f;
#pragma unroll
        for (int j = 0; j < 4; ++j) { v[j] = xr[64 * j]; s += (v[j].x * v[j].x + v[j].y * v[j].y) + (v[j].z * v[j].z + v[j].w * v[j].w); }
        const float rstd = rsqrtf(wave_sum(s) * (1.f / D) + EPS);
        if (mode == 1) { if (lane == 0) RS[row] = rstd; continue; }
        const float* mp = modl + mod_set(row) * 6144;
        const f32x4* gp = (const f32x4*)gvec + lane; const f32x4* shp = (const f32x4*)(mp + shift_idx * 1024) + lane; const f32x4* scp = (const f32x4*)(mp + scale_idx * 1024) + lane;
        u32x2* o8 = (u32x2*)(XN + (size_t)row * D) + lane;
#pragma unroll
        for (int j = 0; j < 4; ++j) { const f32x4 g = gp[64 * j], sh = shp[64 * j], sc = scp[64 * j];
            const f32x4 h = v[j] * rstd * g * (sc + 1.f) + sh;
            u32x2 w; w.x = pk2(h.x, h.y); w.y = pk2(h.z, h.w); o8[64 * j] = w; }
    }
}

DI void rope8(float* x, const float* px, int q8, int t) {
    const int half = q8 >> 2, q4 = q8 & 3; const float pos = half ? (float)(t & 63) : (float)(t >> 6);
    const int f0 = 8 * (q4 & 1);
#pragma unroll
    for (int e = 0; e < 8; ++e) { const float fr = exp2f(-(float)(f0 + e) * (13.287712379549449f / 16.f)); float sn, cs; sincosf(pos * fr, &sn, &cs);
        x[e] = (q4 < 2) ? (x[e] * cs - px[e] * sn) : (x[e] * cs + px[e] * sn); }
}

DI void phase_r1(const P& a, int i, int lane, int wave, int G, int bid) {
    unsigned char* ws = a.ws;
    const bf16_t* PROJ = (const bf16_t*)(ws + WS_BIG);
    bf16_t* RB = (bf16_t*)(ws + WS_RB); bf16_t* KB = (bf16_t*)(ws + WS_KB); bf16_t* VB = (bf16_t*)(ws + WS_VB); bf16_t* KKB = (bf16_t*)(ws + WS_KKB);
    bf16_t* Lm = (bf16_t*)(ws + WS_L); bf16_t* CQ = (bf16_t*)(ws + WS_CQ); bf16_t* CKV = (bf16_t*)(ws + WS_CKV); bf16_t* KRB = (bf16_t*)(ws + WS_KRB);
    const float* mu = a.in[I_MU] + i * 1792; const float* k_k = a.in[I_KK] + i * 512;
    const float* cq_g = a.in[I_CQG] + i * 384; const float* ckv_g = a.in[I_CKVG] + i * 256; const float* kr_g = a.in[I_KRG] + i * 64;
    const int gw = bid * NWAVES + wave, NGW = G * NWAVES;
    for (int row = gw; row < NKV; row += NGW) {
        if (row >= NT) {
            const int rr = row - NT, b2 = rr >> 8, t = rr & 255;
            const f32x4 v = *((const f32x4*)(a.in[I_CCKV] + ((size_t)(b2 * 2 + i) * 256 + t) * 256) + lane);
            u32x2 w; w.x = pk2(v.x, v.y); w.y = pk2(v.z, v.w); *((u32x2*)(CKV + (size_t)row * 256) + lane) = w;
            if (lane < 16) { const f32x4 k4 = *((const f32x4*)(a.in[I_CKR] + ((size_t)(b2 * 2 + i) * 256 + t) * 64) + lane);
                u32x2 w2; w2.x = pk2(k4.x, k4.y); w2.y = pk2(k4.z, k4.w); *((u32x2*)(KRB + (size_t)row * 64) + lane) = w2; }
            continue;
        }
        const bool ctx = row < NCTX; const int t = ctx ? (row & 255) : ((row - NCTX) & 2047); const int T = ctx ? TCTX : TLAT;
        const bool hp = t > 0, hn = t < T - 1;
        const bf16_t* p0 = PROJ + (size_t)row * IN_PAD;
#pragma unroll
        for (int j = 0; j < 3; ++j) {
            const int c = 512 * j + 8 * lane;
            float x0[8], xm[8], xp[8];
            unpack8(*(const u32x4*)(p0 + c), x0);
            if (hp) unpack8(*(const u32x4*)(p0 - IN_PAD + c), xm); else { for (int e = 0; e < 8; ++e) xm[e] = 0.f; }
            if (hn) unpack8(*(const u32x4*)(p0 + IN_PAD + c), xp); else { for (int e = 0; e < 8; ++e) xp[e] = 0.f; }
            const f32x4 m0 = *(const f32x4*)(mu + c), m1 = *(const f32x4*)(mu + c + 4);
            float rw[8];
#pragma unroll
            for (int e = 0; e < 8; ++e) { const float m = e < 4 ? m0[e & 3] : m1[e & 3]; rw[e] = x0[e] + m * (0.5f * (xm[e] + xp[e]) - x0[e]); }
            bf16_t* dst = (j == 0 ? RB : (j == 1 ? KB : VB));
            *(u32x4*)(dst + (size_t)row * 512 + 8 * lane) = pack8(rw);
            if (j == 1) {
                const f32x4 q0 = *(const f32x4*)(k_k + 8 * lane), q1 = *(const f32x4*)(k_k + 8 * lane + 4);
                float kk[8]; float ss = 0.f;
#pragma unroll
                for (int e = 0; e < 8; ++e) { kk[e] = rw[e] * (e < 4 ? q0[e & 3] : q1[e & 3]); ss += kk[e] * kk[e]; }
                ss += __shfl_xor(ss, 1); ss += __shfl_xor(ss, 2); ss += __shfl_xor(ss, 4);
                const float inv = 1.f / (sqrtf(ss) + 1e-12f);
#pragma unroll
                for (int e = 0; e < 8; ++e) kk[e] *= inv;
                *(u32x4*)(KKB + (size_t)row * 512 + 8 * lane) = pack8(kk);
            }
        }
        float cqa[8]; float ssq = 0.f;
        {
            const int c = 1536 + 8 * lane;
            float x0[8]; unpack8(*(const u32x4*)(p0 + c), x0);
            if (lane < 32) {
                float xm[8], xp[8];
                if (hp) unpack8(*(const u32x4*)(p0 - IN_PAD + c), xm); else { for (int e = 0; e < 8; ++e) xm[e] = 0.f; }
                if (hn) unpack8(*(const u32x4*)(p0 + IN_PAD + c), xp); else { for (int e = 0; e < 8; ++e) xp[e] = 0.f; }
                const f32x4 m0 = *(const f32x4*)(mu + c), m1 = *(const f32x4*)(mu + c + 4);
                float lv[8];
#pragma unroll
                for (int e = 0; e < 8; ++e) { const float m = e < 4 ? m0[e & 3] : m1[e & 3]; const float rwv = x0[e] + m * (0.5f * (xm[e] + xp[e]) - x0[e]);
                    lv[e] = lane < 8 ? tanhf(rwv) : (lane < 16 ? rwv : sigm(rwv)); }
                *(u32x4*)(Lm + (size_t)row * 256 + 8 * lane) = pack8(lv);
#pragma unroll
                for (int e = 0; e < 8; ++e) cqa[e] = 0.f;
            } else {
#pragma unroll
                for (int e = 0; e < 8; ++e) { cqa[e] = x0[e]; ssq += x0[e] * x0[e]; }
            }
        }
        float xb[8]; unpack8(*(const u32x4*)(p0 + 2048 + 8 * lane), xb);
        float sb = 0.f;
#pragma unroll
        for (int e = 0; e < 8; ++e) sb += xb[e] * xb[e];
        const float tq = wave_sum(ssq + (lane < 16 ? sb : 0.f));
        const float tkv = wave_sum((lane >= 16 && lane < 48) ? sb : 0.f);
        const float tkr = wave_sum((lane >= 48 && lane < 56) ? sb : 0.f);
        const float rq = rsqrtf(tq * (1.f / 384.f) + EPS), rkv = rsqrtf(tkv * (1.f / 256.f) + EPS), rkr = rsqrtf(tkr * (1.f / 64.f) + EPS);
        if (lane >= 32) { const int ci = 8 * (lane - 32); float o[8];
#pragma unroll
            for (int e = 0; e < 8; ++e) o[e] = cqa[e] * rq * cq_g[ci + e];
            *(u32x4*)(CQ + (size_t)row * 384 + ci) = pack8(o); }
        if (lane < 16) { const int ci = 256 + 8 * lane; float o[8];
#pragma unroll
            for (int e = 0; e < 8; ++e) o[e] = xb[e] * rq * cq_g[ci + e];
            *(u32x4*)(CQ + (size_t)row * 384 + ci) = pack8(o); }
        if (lane >= 16 && lane < 48) { const int ci = 8 * (lane - 16); float o[8];
#pragma unroll
            for (int e = 0; e < 8; ++e) o[e] = xb[e] * rkv * ckv_g[ci + e];
            *(u32x4*)(CKV + (size_t)row * 256 + ci) = pack8(o);
            if (ctx) { float* dst = a.out + OUT_CKV + ((size_t)((row >> 8) * 2 + i) * 256 + t) * 256 + ci;
                *(f32x4*)dst = (f32x4){o[0], o[1], o[2], o[3]}; *(f32x4*)(dst + 4) = (f32x4){o[4], o[5], o[6], o[7]}; } }
        { const int q8 = (lane - 48) & 7; float o[8], po[8];
#pragma unroll
            for (int e = 0; e < 8; ++e) o[e] = xb[e] * rkr * kr_g[8 * q8 + e];
#pragma unroll
            for (int e = 0; e < 8; ++e) po[e] = __shfl_xor(o[e], 2);
            if (lane >= 48 && lane < 56) {
                if (ctx) { float* dst = a.out + OUT_KR + ((size_t)((row >> 8) * 2 + i) * 256 + t) * 64 + 8 * q8;
                    *(f32x4*)dst = (f32x4){o[0], o[1], o[2], o[3]}; *(f32x4*)(dst + 4) = (f32x4){o[4], o[5], o[6], o[7]}; }
                else rope8(o, po, q8, t);
                *(u32x4*)(KRB + (size_t)row * 64 + 8 * q8) = pack8(o); } }
    }
}

DI void phase_m3(const P& a, int i, int lane, int wave, int G, int bid) {
    unsigned char* ws = a.ws;
    const bf16_t* QRAW = (const bf16_t*)(ws + WS_QRAW); const bf16_t* KVRAW = (const bf16_t*)(ws + WS_KVRAW);
    bf16_t* QF = (bf16_t*)(ws + WS_QF); bf16_t* KF = (bf16_t*)(ws + WS_KF);
    const float* qn_g = a.in[I_QNG] + i * 128; const float* qr_g = a.in[I_QRG] + i * 64; const float* kn_g = a.in[I_KNG] + i * 128;
    const int gw = bid * NWAVES + wave, NGW = G * NWAVES;
    for (int row = gw; row < NKV; row += NGW) {
#pragma unroll
        for (int j = 0; j < 2; ++j) {
            float x[8]; unpack8(*(const u32x4*)(KVRAW + (size_t)row * 1024 + 512 * j + 8 * lane), x);
            float ss = 0.f;
#pragma unroll
            for (int e = 0; e < 8; ++e) ss += x[e] * x[e];
            ss += __shfl_xor(ss, 1); ss += __shfl_xor(ss, 2); ss += __shfl_xor(ss, 4); ss += __shfl_xor(ss, 8);
            const int seg = lane >> 4;
            if ((seg & 1) == 0) { const float r = rsqrtf(ss * (1.f / 128.f) + EPS); const int h = 2 * j + (seg >> 1), ci = 8 * (lane & 15); float o[8];
#pragma unroll
                for (int e = 0; e < 8; ++e) o[e] = x[e] * r * kn_g[ci + e];
                *(u32x4*)(KF + (size_t)row * 512 + h * 128 + ci) = pack8(o); }
        }
        if (row >= NT) continue;
        const bool lat = row >= NCTX; const int t = (row - NCTX) & 2047;
#pragma unroll
        for (int j = 0; j < 2; ++j) {
            const int c = 512 * j + 8 * lane; const bool act = (j == 0) || (lane < 32);
            float x[8];
            if (act) unpack8(*(const u32x4*)(QRAW + (size_t)row * 768 + c), x); else { for (int e = 0; e < 8; ++e) x[e] = 0.f; }
            float ss = 0.f;
#pragma unroll
            for (int e = 0; e < 8; ++e) ss += x[e] * x[e];
            ss += __shfl_xor(ss, 1); ss += __shfl_xor(ss, 2); ss += __shfl_xor(ss, 4);
            const int g64 = c >> 6, part = g64 % 3;
            const float up = __shfl(ss, (lane + 8) & 63), dn = __shfl(ss, (lane - 8) & 63);
            const float tot = part == 0 ? ss + up : (part == 1 ? ss + dn : ss);
            const float r = rsqrtf(tot * (part == 2 ? (1.f / 64.f) : (1.f / 128.f)) + EPS);
            const int q8 = lane & 7;
            float o[8], po[8];
#pragma unroll
            for (int e = 0; e < 8; ++e) { const float g = part == 2 ? qr_g[8 * q8 + e] : qn_g[part * 64 + 8 * q8 + e]; o[e] = x[e] * r * g; }
#pragma unroll
            for (int e = 0; e < 8; ++e) po[e] = __shfl_xor(o[e], 2);
            if (part == 2 && lat) rope8(o, po, q8, t);
#pragma unroll
            for (int e = 0; e < 8; ++e) o[e] *= QSCALE;
            if (act) *(u32x4*)(QF + (size_t)row * 768 + c) = pack8(o);
        }
    }
}

constexpr int KLD = 200, VLD = 136;
DI int crow(int r, int hi) { return (r & 3) + 8 * (r >> 2) + 4 * hi; }
DI void attn_unit(const P& a, int seq, int h, int qb, LAS unsigned char* lds, int tid, int lane, int wave) {
    unsigned char* ws = a.ws;
    const bf16_t* QF = (const bf16_t*)(ws + WS_QF); const bf16_t* KF = (const bf16_t*)(ws + WS_KF); const bf16_t* KRB = (const bf16_t*)(ws + WS_KRB); const bf16_t* KVRAW = (const bf16_t*)(ws + WS_KVRAW);
    bf16_t* AB = (bf16_t*)(ws + WS_XN);
    const bool ctx = seq < 32; const int nkeys = ctx ? 256 : 2304;
    const int qrow0 = (ctx ? seq * 256 : NCTX + (seq - 32) * 2048 + qb * 256) + wave * 32;
    LAS bf16_t* Kl = (LAS bf16_t*)lds; LAS bf16_t* Vl = (LAS bf16_t*)(lds + 64 * KLD * 2);
    const int r32 = lane & 31, hi = lane >> 5;
    bf16x8 qf[12];
#pragma unroll
    for (int s = 0; s < 12; ++s) qf[s] = *(const bf16x8*)(QF + (size_t)(qrow0 + r32) * 768 + h * 192 + 16 * s + 8 * hi);
    f32x16 o[4];
#pragma unroll
    for (int d = 0; d < 4; ++d)
#pragma unroll
        for (int e = 0; e < 16; ++e) o[d][e] = 0.f;
    float m_run = -1e30f, l_run = 0.f;
    const int vbase = ((4 * hi + ((lane & 15) >> 2)) * VLD + 16 * ((lane >> 4) & 1) + 4 * (lane & 3)) * 2;
    u32x4 pk[3], pv[2];
    auto att_kvrow = [&](int key0) { return ctx ? seq * 256 + key0 : (key0 < 2048 ? NCTX + (seq - 32) * 2048 + key0 : NT + (seq - 32) * 256 + key0 - 2048); };
#define ATT_LOAD(key0_) do { const int kvr_ = att_kvrow(key0_); \
        _Pragma("unroll") for (int it = 0; it < 3; ++it) { const int e = tid + it * NTHR; const int kr = e / 24, ch = e % 24; \
            pk[it] = (ch < 16) ? *(const u32x4*)(KF + (size_t)(kvr_ + kr) * 512 + h * 128 + 8 * ch) : *(const u32x4*)(KRB + (size_t)(kvr_ + kr) * 64 + 8 * (ch - 16)); } \
        _Pragma("unroll") for (int it = 0; it < 2; ++it) { const int e = tid + it * NTHR; const int kr = e >> 4, ch = e & 15; \
            pv[it] = *(const u32x4*)(KVRAW + (size_t)(kvr_ + kr) * 1024 + h * 256 + 128 + 8 * ch); } } while (0)
    ATT_LOAD(0);
    const int ntile = nkeys / 64;
    for (int kt = 0; kt < ntile; ++kt) {
        asm volatile("s_waitcnt lgkmcnt(0)" ::: "memory"); __builtin_amdgcn_s_barrier(); asm volatile("" ::: "memory");
#pragma unroll
        for (int it = 0; it < 3; ++it) { const int e = tid + it * NTHR; const int kr = e / 24, ch = e % 24; *(LAS u32x4*)(Kl + kr * KLD + 8 * ch) = pk[it]; }
#pragma unroll
        for (int it = 0; it < 2; ++it) { const int e = tid + it * NTHR; const int kr = e >> 4, ch = e & 15; *(LAS u32x4*)(Vl + kr * VLD + 8 * ch) = pv[it]; }
        if (kt + 1 < ntile) ATT_LOAD((kt + 1) * 64);
        asm volatile("s_waitcnt lgkmcnt(0)" ::: "memory"); __builtin_amdgcn_s_barrier(); asm volatile("" ::: "memory");
        f32x16 p[2];
#pragma unroll
        for (int kb = 0; kb < 2; ++kb) {
#pragma unroll
            for (int e = 0; e < 16; ++e) p[kb][e] = 0.f;
#pragma unroll
            for (int sg = 0; sg < 3; ++sg) {
                bf16x8 kf[4];
#pragma unroll
                for (int s4 = 0; s4 < 4; ++s4) kf[s4] = *(const LAS bf16x8*)(Kl + (32 * kb + r32) * KLD + 16 * (4 * sg + s4) + 8 * hi);
#pragma unroll
                for (int s4 = 0; s4 < 4; ++s4) p[kb] = __builtin_amdgcn_mfma_f32_32x32x16_bf16(kf[s4], qf[4 * sg + s4], p[kb], 0, 0, 0);
                __builtin_amdgcn_sched_barrier(0);
            }
        }
        float mx = p[0][0];
#pragma unroll
        for (int e = 1; e < 16; ++e) mx = fmaxf(mx, p[0][e]);
#pragma unroll
        for (int e = 0; e < 16; ++e) mx = fmaxf(mx, p[1][e]);
        mx = fmaxf(mx, __shfl_xor(mx, 32));
        const float m_new = fmaxf(m_run, mx); const float alpha = __builtin_amdgcn_exp2f(m_run - m_new); m_run = m_new;
        float rs = 0.f;
#pragma unroll
        for (int kb = 0; kb < 2; ++kb)
#pragma unroll
            for (int e = 0; e < 16; ++e) { p[kb][e] = __builtin_amdgcn_exp2f(p[kb][e] - m_new); rs += p[kb][e]; }
        l_run = l_run * alpha + rs;
#pragma unroll
        for (int d = 0; d < 4; ++d)
#pragma unroll
            for (int e = 0; e < 16; ++e) o[d][e] *= alpha;
#pragma unroll
        for (int kb = 0; kb < 2; ++kb)
#pragma unroll
            for (int s = 0; s < 2; ++s) {
                u32x4 pw; pw.x = pk2(p[kb][8 * s + 0], p[kb][8 * s + 1]); pw.y = pk2(p[kb][8 * s + 2], p[kb][8 * s + 3]); pw.z = pk2(p[kb][8 * s + 4], p[kb][8 * s + 5]); pw.w = pk2(p[kb][8 * s + 6], p[kb][8 * s + 7]);
                const bf16x8 pb = __builtin_bit_cast(bf16x8, pw);
                const int krow0 = 32 * kb + 16 * s;
#pragma unroll
                for (int d = 0; d < 4; ++d) {
                    typedef short v4i16_t __attribute__((ext_vector_type(4)));
                    const LAS unsigned char* vp = (const LAS unsigned char*)Vl + vbase + (krow0 * VLD + 32 * d) * 2;
                    const v4i16_t lo = __builtin_amdgcn_ds_read_tr16_b64_v4i16((LAS v4i16_t*)vp);
                    const v4i16_t hh = __builtin_amdgcn_ds_read_tr16_b64_v4i16((LAS v4i16_t*)(vp + 8 * VLD * 2));
                    const bf16x8 va = (bf16x8){lo[0], lo[1], lo[2], lo[3], hh[0], hh[1], hh[2], hh[3]};
                    o[d] = __builtin_amdgcn_mfma_f32_32x32x16_bf16(va, pb, o[d], 0, 0, 0);
                }
                __builtin_amdgcn_sched_barrier(0);
            }
    }
    const float lt = l_run + __shfl_xor(l_run, 32); const float inv = 1.f / lt;
    bf16_t* orow = AB + (size_t)(qrow0 + r32) * 1024 + 512 + h * 128;
#pragma unroll
    for (int d = 0; d < 4; ++d)
#pragma unroll
        for (int g = 0; g < 4; ++g) { u32x2 w; w.x = pk2(o[d][4 * g] * inv, o[d][4 * g + 1] * inv); w.y = pk2(o[d][4 * g + 2] * inv, o[d][4 * g + 3] * inv);
            *(u32x2*)(orow + 32 * d + 8 * g + 4 * hi) = w; }
    __syncthreads();
}

DI void phase_r3(const P& a, int i, int lane, int wave, int G, int bid) {
    unsigned char* ws = a.ws;
    const bf16_t* RB = (const bf16_t*)(ws + WS_RB); const bf16_t* KB = (const bf16_t*)(ws + WS_KB); const bf16_t* VB = (const bf16_t*)(ws + WS_VB);
    const bf16_t* LO = (const bf16_t*)(ws + WS_BIG); const float* Y0 = (const float*)(ws + WS_Y0); const float* Y1 = Y0 + (size_t)NT * 512;
    bf16_t* AB = (bf16_t*)(ws + WS_XN);
    const float* ln_g = a.in[I_LNG] + i * 512; const float* ln_b = a.in[I_LNB] + i * 512; const float* r_k = a.in[I_RK] + i * 512;
    const int gw = bid * NWAVES + wave, NGW = G * NWAVES; const int c = 8 * lane;
    for (int row = gw; row < NT; row += NGW) {
        const size_t o5 = (size_t)row * 512 + c;
        const f32x4 a0 = *(const f32x4*)(Y0 + o5), a1 = *(const f32x4*)(Y0 + o5 + 4), b0 = *(const f32x4*)(Y1 + o5), b1 = *(const f32x4*)(Y1 + o5 + 4);
        float y[8] = {a0.x + b0.x, a0.y + b0.y, a0.z + b0.z, a0.w + b0.w, a1.x + b1.x, a1.y + b1.y, a1.z + b1.z, a1.w + b1.w};
        float sm = 0.f;
#pragma unroll
        for (int e = 0; e < 8; ++e) sm += y[e];
        sm += __shfl_xor(sm, 1); sm += __shfl_xor(sm, 2); sm += __shfl_xor(sm, 4);
        const float mu = sm * (1.f / 64.f); float sv = 0.f;
#pragma unroll
        for (int e = 0; e < 8; ++e) { y[e] -= mu; sv += y[e] * y[e]; }
        sv += __shfl_xor(sv, 1); sv += __shfl_xor(sv, 2); sv += __shfl_xor(sv, 4);
        const float rstd = rsqrtf(sv * (1.f / 64.f) + GN_EPS);
        float r[8], k[8], v[8], g[8];
        unpack8(*(const u32x4*)(RB + o5), r); unpack8(*(const u32x4*)(KB + o5), k); unpack8(*(const u32x4*)(VB + o5), v);
        unpack8(*(const u32x4*)(LO + (size_t)row * IN_PAD + 2048 + c), g);
        float dt = 0.f;
#pragma unroll
        for (int e = 0; e < 8; ++e) dt += r[e] * k[e] * r_k[c + e];
        dt += __shfl_xor(dt, 1); dt += __shfl_xor(dt, 2); dt += __shfl_xor(dt, 4);
        float o[8];
#pragma unroll
        for (int e = 0; e < 8; ++e) o[e] = (y[e] * rstd * ln_g[c + e] + ln_b[c + e] + dt * v[e]) * g[e];
        *(u32x4*)(AB + (size_t)row * 1024 + c) = pack8(o);
    }
}

DI void phase_p1(const P& a, int l, int lane, int wave, int G, int bid) {
    unsigned char* ws = a.ws;
    const float* Y = a.out + OUT_Y; const float* RS = (const float*)(ws + WS_RS); bf16_t* Dm = (bf16_t*)(ws + WS_XN);
    const float* gvec = a.in[I_N1G] + l * 1024; const float* modl = (const float*)(ws + WS_MOD) + (size_t)l * 3 * 6144;
    const int gw = bid * NWAVES + wave, NGW = G * NWAVES;
    for (int row = gw; row < NT; row += NGW) {
        const bool ctx = row < NCTX; const int t = ctx ? (row & 255) : ((row - NCTX) & 2047); const int T = ctx ? TCTX : TLAT; const int base = row - t;
        const float* scp = modl + mod_set(row) * 6144 + 1 * 1024;
        const float rst = RS[row];
#pragma unroll
        for (int j = 0; j < 4; ++j) {
            const int hw = 1 << j;
            const int lo = max(t - hw, 0), hi = min(t + hw, T);
            const int c = 256 * j + 4 * lane;
            f32x4 sum = (f32x4){0.f, 0.f, 0.f, 0.f};
            for (int tt = lo; tt < hi; ++tt) sum += *(const f32x4*)(Y + (size_t)(base + tt) * D + c) * RS[base + tt];
            const f32x4 nt = *(const f32x4*)(Y + (size_t)row * D + c) * rst;
            const f32x4 gg = *(const f32x4*)(gvec + c) * (*(const f32x4*)(scp + c) + 1.f);
            const f32x4 d = gg * (sum * (1.f / (float)(hi - lo)) - nt);
            u32x2 w; w.x = pk2(d.x, d.y); w.y = pk2(d.z, d.w);
            *(u32x2*)(Dm + (size_t)row * D + c) = w;
        }
    }
}

#define CS_LAUNDER(x) asm volatile("" : "+v"(x))
#define CS_BAR() do { asm volatile("s_waitcnt lgkmcnt(0)" ::: "memory"); __builtin_amdgcn_s_barrier(); asm volatile("" ::: "memory"); } while (0)
constexpr int CP = 72;
constexpr int CB = 64 * CP * 2;
constexpr int B_PM = 0 * CB, B_QM = 1 * CB, B_KT = 2 * CB, B_RT = 3 * CB, B_PMT = 4 * CB, B_QMT = 5 * CB, B_KTT = 6 * CB, B_VM = 7 * CB,
              B_AKP = 8 * CB, B_BKR = 9 * CB, B_BQR = 10 * CB, B_ATF = 11 * CB, B_GMT = 12 * CB, B_PHT = 13 * CB, B_GC = 14 * CB;
constexpr int B_TT = B_PM, B_A12T = B_GMT, B_T11 = B_PHT, B_EWCS = B_AKP, B_TOT = B_BQR;
static_assert(B_GC + 256 <= RING_BYTES, "scan LDS map");
typedef short s16x4 __attribute__((ext_vector_type(4)));

DI bf16x8 cs_frag(const LAS unsigned char* M, int row, int col) { return *(const LAS bf16x8*)(M + (row * CP + col) * 2); }
DI bf16x8 cs_frag_krow(const LAS unsigned char* M, int row, int col0, int hi) {
    const s16x4 x = *(const LAS s16x4*)(M + (row * CP + col0 + 4 * hi) * 2), y = *(const LAS s16x4*)(M + (row * CP + col0 + 8 + 4 * hi) * 2);
    return (bf16x8){x[0], x[1], x[2], x[3], y[0], y[1], y[2], y[3]};
}
DI bf16x8 cs_pack(const f32x16& x, int s, unsigned sgn) {
    u32x4 p; p.x = pk2(x[8 * s + 0], x[8 * s + 1]) ^ sgn; p.y = pk2(x[8 * s + 2], x[8 * s + 3]) ^ sgn; p.z = pk2(x[8 * s + 4], x[8 * s + 5]) ^ sgn; p.w = pk2(x[8 * s + 6], x[8 * s + 7]) ^ sgn;
    return __builtin_bit_cast(bf16x8, p);
}
#define CS_MFMA(a_, b_, c_) __builtin_amdgcn_mfma_f32_32x32x16_bf16((a_), (b_), (c_), 0, 0, 0)
DI f32x16 cs_zero() { f32x16 z; for (int e = 0; e < 16; ++e) z[e] = 0.f; return z; }
DI void cs_store_nat(LAS unsigned char* M, const f32x16& x, int rb, int cb, int r32, int hi) {
#pragma unroll
    for (int g = 0; g < 4; ++g) { u32x2 w; w.x = pk2(x[4 * g], x[4 * g + 1]); w.y = pk2(x[4 * g + 2], x[4 * g + 3]);
        *(LAS u32x2*)(M + ((32 * cb + r32) * CP + 32 * rb + 8 * g + 4 * hi) * 2) = w; }
}

struct ScanLoads { u32x4 r, k, v, kk, ew, av; };
DI void scan_load(ScanLoads& L, const P& a, int i, int tok, int h, int dir, int kq) {
    const unsigned char* ws = a.ws; const size_t o = (size_t)tok * 512 + h * 64 + 8 * kq;
    L.r = *(const u32x4*)((const bf16_t*)(ws + WS_RB) + o); L.k = *(const u32x4*)((const bf16_t*)(ws + WS_KB) + o); L.v = *(const u32x4*)((const bf16_t*)(ws + WS_VB) + o);
    L.kk = *(const u32x4*)((const bf16_t*)(ws + WS_KKB) + o);
    const bf16_t* lo = (const bf16_t*)(ws + WS_BIG) + (size_t)tok * IN_PAD + dir * 512 + h * 64 + 8 * kq;
    L.ew = *(const u32x4*)lo; L.av = *(const u32x4*)(lo + 1024);
}

DI void scan_chain(const P& a, int i, int seq, int h, int dir, int cbeg, int cend, bool local, LAS unsigned char* lds, int tid, int lane, int wave) {
    const bool ctx = seq < 32; const int T = ctx ? TCTX : TLAT; const int tok_base = ctx ? seq * 256 : NCTX + (seq - 32) * 2048;
    const int nch = T / 64;
    float* Yd = (float*)(a.ws + WS_Y0) + (size_t)dir * NT * 512;
    const float* k_a = a.in[I_KA] + i * 512 + h * 64;
    const int vb = wave - 1;
    const int kb = wave - 3;
    LAS float* GC = (LAS float*)(lds + B_GC);
    bf16x8 sp00, sp01, sp10, sp11;
    {
        f32x16 st0 = cs_zero(), st1 = cs_zero();
        if ((wave == 1 || wave == 2) && !ctx && !local) {
            const int r32 = lane & 31, hi = lane >> 5;
            const float* sp = a.in[I_STATE] + ((((size_t)((seq - 32) * 2 + i) * 2 + dir) * 8 + h) * 64 + 32 * vb + r32) * 64;
#pragma unroll
            for (int g = 0; g < 4; ++g) { const f32x4 x0 = *(const f32x4*)(sp + 8 * g + 4 * hi), x1 = *(const f32x4*)(sp + 32 + 8 * g + 4 * hi);
#pragma unroll
                for (int e = 0; e < 4; ++e) { st0[4 * g + e] = x0[e]; st1[4 * g + e] = x1[e]; } }
        }
        sp00 = cs_pack(st0, 0, 0u); sp01 = cs_pack(st0, 1, 0u); sp10 = cs_pack(st1, 0, 0u); sp11 = cs_pack(st1, 1, 0u);
    }
    ScanLoads L;
    { const int tau = cbeg * 64 + (tid >> 3); scan_load(L, a, i, dir ? tok_base + T - 1 - tau : tok_base + tau, h, dir, tid & 7); }
    for (int c = cbeg; c < cend; ++c) {
        int td_ = tid; CS_LAUNDER(td_);
        const int pj = td_ >> 3, pkq = td_ & 7;
        const int ck = td_ & 63, cjg = td_ >> 6;
        float ewf[8];
        unpack8(L.ew, ewf);
        { LAS float* e = (LAS float*)(lds + B_EWCS) + pj * 64 + 8 * pkq; *(LAS f32x4*)e = (f32x4){ewf[0], ewf[1], ewf[2], ewf[3]}; *(LAS f32x4*)(e + 4) = (f32x4){ewf[4], ewf[5], ewf[6], ewf[7]}; }
        CS_BAR();
        { LAS float* E = (LAS float*)(lds + B_EWCS); LAS float* TOT = (LAS float*)(lds + B_TOT);
          float x[8]; float run = 0.f;
#pragma unroll
          for (int e = 0; e < 8; ++e) { run += E[(8 * cjg + e) * 64 + ck]; x[e] = run; }
          TOT[cjg * 64 + ck] = run;
          CS_BAR();
          float off = 0.f;
#pragma unroll
          for (int g = 0; g < 7; ++g) off += (g < cjg) ? TOT[g * 64 + ck] : 0.f;
#pragma unroll
          for (int e = 0; e < 8; ++e) E[(8 * cjg + e) * 64 + ck] = x[e] + off;
        }
        CS_BAR();
#ifndef CS_REP_PREP
#define CS_REP_PREP 1
#endif
        for (int rep_ = 0; rep_ < CS_REP_PREP; ++rep_) {
        if (rep_) CS_BAR();
        {
            float csv[8], rf[8], kf[8], vf[8], kkf[8], af[8];
            { const LAS float* e = (const LAS float*)(lds + B_EWCS) + pj * 64 + 8 * pkq; const f32x4 c0 = *(const LAS f32x4*)e, c1 = *(const LAS f32x4*)(e + 4);
              csv[0] = c0[0]; csv[1] = c0[1]; csv[2] = c0[2]; csv[3] = c0[3]; csv[4] = c1[0]; csv[5] = c1[1]; csv[6] = c1[2]; csv[7] = c1[3]; }
            unpack8(L.r, rf); unpack8(L.k, kf); unpack8(L.v, vf); unpack8(L.kk, kkf); unpack8(L.av, af);
            float pv[8], qv[8], ktv[8], rtv[8];
#pragma unroll
            for (int e = 0; e < 8; ++e) { const float cl = csv[e] * 1.4426950408889634f; const float g = __builtin_amdgcn_exp2f(-cl), gi = __builtin_amdgcn_exp2f(cl), gm = __builtin_amdgcn_exp2f(ewf[e] * 1.4426950408889634f - cl);
                const float kd = kf[e] * (1.f + (af[e] - 1.f) * k_a[8 * pkq + e]);
                pv[e] = kkf[e] * gm; qv[e] = kkf[e] * af[e] * gi; ktv[e] = kd * gi; rtv[e] = rf[e] * g;
                if (pj == 63) GC[8 * pkq + e] = g; }
            *(LAS u32x4*)(lds + B_PM + (pj * CP + 8 * pkq) * 2) = pack8(pv); *(LAS u32x4*)(lds + B_QM + (pj * CP + 8 * pkq) * 2) = pack8(qv);
            *(LAS u32x4*)(lds + B_KT + (pj * CP + 8 * pkq) * 2) = pack8(ktv); *(LAS u32x4*)(lds + B_RT + (pj * CP + 8 * pkq) * 2) = pack8(rtv);
            *(LAS u32x4*)(lds + B_ATF + (pj * CP + 8 * pkq) * 2) = L.v;
        }
        CS_BAR();
        {
#pragma unroll
            for (int m = 0; m < 4; ++m) {
                const LAS unsigned char* src = lds + (m == 0 ? B_PM : m == 1 ? B_QM : m == 2 ? B_KT : B_ATF);
                LAS unsigned char* dst = lds + (m == 0 ? B_PMT : m == 1 ? B_QMT : m == 2 ? B_KTT : B_VM);
                unsigned h8[8];
#pragma unroll
                for (int e = 0; e < 8; ++e) h8[e] = *(const LAS bf16_t*)(src + ((8 * cjg + e) * CP + ck) * 2);
                u32x4 o; o.x = h8[0] | (h8[1] << 16); o.y = h8[2] | (h8[3] << 16); o.z = h8[4] | (h8[5] << 16); o.w = h8[6] | (h8[7] << 16);
                *(LAS u32x4*)(dst + (ck * CP + 8 * cjg) * 2) = o;
            }
        }
        }
        CS_BAR();
        {
            int ln_ = lane; CS_LAUNDER(ln_); const int r32 = ln_ & 31, hi = ln_ >> 5;
            const int pr = wave >> 1, ib = wave & 1;
            const LAS unsigned char* Am = lds + ((pr == 0 || pr == 3) ? B_QM : B_KT);
            const LAS unsigned char* Bm = lds + ((pr < 2) ? B_PM : B_RT);
            f32x16 d0 = cs_zero(), d1 = cs_zero();
#pragma unroll
            for (int s = 0; s < 4; ++s) { const bf16x8 af = cs_frag(Am, 32 * ib + r32, 16 * s + 8 * hi);
                if (ib == 0) d0 = CS_MFMA(af, cs_frag(Bm, r32, 16 * s + 8 * hi), d0);
                d1 = CS_MFMA(af, cs_frag(Bm, 32 + r32, 16 * s + 8 * hi), d1); }
            const int incl = pr >> 1;
#pragma unroll
            for (int e = 0; e < 16; ++e) { const int il = crow(e, hi);
                if (ib == 0) { if (!(il < r32 + incl)) d0[e] = 0.f; }
                else { d0[e] = 0.f; if (!(il < r32 + incl)) d1[e] = 0.f; } }
            if (pr == 0) {
                LAS float* ATF = (LAS float*)(lds + B_ATF);
                if (ib == 0) {
#pragma unroll
                    for (int g = 0; g < 4; ++g) *(LAS f32x4*)(ATF + r32 * 36 + 8 * g + 4 * hi) = (f32x4){d0[4 * g], d0[4 * g + 1], d0[4 * g + 2], d0[4 * g + 3]};
#pragma unroll
                    for (int g = 0; g < 4; ++g) { u32x2 w; w.x = pk2(d1[4 * g], d1[4 * g + 1]); w.y = pk2(d1[4 * g + 2], d1[4 * g + 3]);
                        *(LAS u32x2*)(lds + B_A12T + (r32 * 40 + 8 * g + 4 * hi) * 2) = w; }
                } else {
#pragma unroll
                    for (int g = 0; g < 4; ++g) *(LAS f32x4*)(ATF + (32 + r32) * 36 + 8 * g + 4 * hi) = (f32x4){d1[4 * g], d1[4 * g + 1], d1[4 * g + 2], d1[4 * g + 3]};
                }
            } else {
                LAS unsigned char* Om = lds + (pr == 1 ? B_AKP : (pr == 2 ? B_BKR : B_BQR));
                cs_store_nat(Om, d0, ib, 0, r32, hi); cs_store_nat(Om, d1, ib, 1, r32, hi);
            }
        }
        CS_BAR();
        if (c + 1 < cend) { int td2 = tid; CS_LAUNDER(td2); const int tau = (c + 1) * 64 + (td2 >> 3); scan_load(L, a, i, dir ? tok_base + T - 1 - tau : tok_base + tau, h, dir, td2 & 7); }
        if (wave == 0) {
            int ln_ = lane; CS_LAUNDER(ln_); const int r32 = ln_ & 31, hi = ln_ >> 5;
            const int b = ln_ >> 5, rl = ln_ & 31;
#ifndef CS_REP_INV
#define CS_REP_INV 1
#endif
            for (int rep_ = 0; rep_ < CS_REP_INV; ++rep_) {
            const LAS float* ATF = (const LAS float*)(lds + B_ATF);
            float t[32];
#pragma unroll
            for (int jl = 0; jl < 32; ++jl) {
                float ps[4] = {0.f, 0.f, 0.f, 0.f};
                const LAS float* col = ATF + (32 * b + jl) * 36;
#pragma unroll
                for (int i4 = 0; i4 < (jl + 3) / 4; ++i4) { const f32x4 a4 = *(const LAS f32x4*)(col + 4 * i4);
#pragma unroll
                    for (int e = 0; e < 4; ++e) if (4 * i4 + e < jl) ps[e] += t[4 * i4 + e] * a4[e]; }
                t[jl] = ((jl == rl) ? 1.f : 0.f) - ((ps[0] + ps[1]) + (ps[2] + ps[3]));
            }
#pragma unroll
            for (int jl = 0; jl < 32; ++jl) *(LAS bf16_t*)(lds + B_TT + ((32 * b + jl) * CP + 32 * b + rl) * 2) = (bf16_t)(pk2(t[jl], 0.f) & 0xffffu);
#pragma unroll
            for (int q = 0; q < 2; ++q) { const int e = ln_ + 64 * q; const int zr = e >> 2, zc = e & 3;
                *(LAS u32x4*)(lds + B_TT + (zr * CP + 32 + 8 * zc) * 2) = (u32x4){0u, 0u, 0u, 0u}; }
            if (b == 0) {
#pragma unroll
                for (int q = 0; q < 4; ++q) { float tmp[8];
#pragma unroll
                    for (int e = 0; e < 8; ++e) tmp[e] = t[8 * q + e];
                    *(LAS u32x4*)(lds + B_T11 + (rl * 40 + 8 * q) * 2) = pack8(tmp); }
            }
            __builtin_amdgcn_fence(__ATOMIC_RELEASE, "wavefront"); asm volatile("s_waitcnt lgkmcnt(0)" ::: "memory");
            f32x16 m1 = cs_zero();
#pragma unroll
            for (int s = 0; s < 2; ++s) { const bf16x8 af = *(const LAS bf16x8*)(lds + B_A12T + (r32 * 40 + 16 * s + 8 * hi) * 2), bf = *(const LAS bf16x8*)(lds + B_T11 + (r32 * 40 + 16 * s + 8 * hi) * 2);
                m1 = CS_MFMA(af, bf, m1); }
            f32x16 z = cs_zero();
#pragma unroll
            for (int s = 0; s < 2; ++s) z = CS_MFMA(cs_pack(m1, s, 0u), cs_frag_krow(lds + B_TT, 32 + r32, 32 + 16 * s, hi), z);
#pragma unroll
            for (int g = 0; g < 4; ++g) { u32x2 w; w.x = pk2(-z[4 * g], -z[4 * g + 1]); w.y = pk2(-z[4 * g + 2], -z[4 * g + 3]);
                *(LAS u32x2*)(lds + B_TT + ((32 + r32) * CP + 8 * g + 4 * hi) * 2) = w; }
            }
            CS_BAR();
            CS_BAR();
        } else if (wave == 1 || wave == 2) {
            f32x16 xt0, xt1, psi0, psi1, yl0, yl1;
            {
            int ln_ = lane; CS_LAUNDER(ln_); const int r32 = ln_ & 31, hi = ln_ >> 5;
            xt0 = cs_zero(); xt1 = cs_zero(); psi0 = cs_zero(); psi1 = cs_zero(); yl0 = cs_zero(); yl1 = cs_zero();
#pragma unroll
            for (int s = 0; s < 4; ++s) { const bf16x8 vf = cs_frag(lds + B_VM, 32 * vb + r32, 16 * s + 8 * hi);
                xt0 = CS_MFMA(cs_frag(lds + B_AKP, r32, 16 * s + 8 * hi), vf, xt0); xt1 = CS_MFMA(cs_frag(lds + B_AKP, 32 + r32, 16 * s + 8 * hi), vf, xt1);
                psi0 = CS_MFMA(cs_frag(lds + B_KTT, r32, 16 * s + 8 * hi), vf, psi0); psi1 = CS_MFMA(cs_frag(lds + B_KTT, 32 + r32, 16 * s + 8 * hi), vf, psi1);
                yl0 = CS_MFMA(cs_frag(lds + B_BKR, r32, 16 * s + 8 * hi), vf, yl0); yl1 = CS_MFMA(cs_frag(lds + B_BKR, 32 + r32, 16 * s + 8 * hi), vf, yl1); }
            }
            CS_BAR();
            {
            int ln_ = lane; CS_LAUNDER(ln_); const int r32 = ln_ & 31, hi = ln_ >> 5;
            f32x16 u0 = cs_zero(), u1 = cs_zero();
#pragma unroll
            for (int s = 0; s < 2; ++s) { const bf16x8 xb0 = cs_pack(xt0, s, 0u), xb1 = cs_pack(xt1, s, 0u);
                u0 = CS_MFMA(cs_frag_krow(lds + B_TT, r32, 16 * s, hi), xb0, u0);
                u1 = CS_MFMA(cs_frag_krow(lds + B_TT, 32 + r32, 16 * s, hi), xb0, u1);
                u1 = CS_MFMA(cs_frag_krow(lds + B_TT, 32 + r32, 32 + 16 * s, hi), xb1, u1); }
#pragma unroll
            for (int s = 0; s < 2; ++s) { const bf16x8 n0 = cs_pack(u0, s, 0x80008000u), n1 = cs_pack(u1, s, 0x80008000u);
                psi0 = CS_MFMA(cs_frag_krow(lds + B_QMT, r32, 16 * s, hi), n0, psi0); psi0 = CS_MFMA(cs_frag_krow(lds + B_QMT, r32, 32 + 16 * s, hi), n1, psi0);
                psi1 = CS_MFMA(cs_frag_krow(lds + B_QMT, 32 + r32, 16 * s, hi), n0, psi1); psi1 = CS_MFMA(cs_frag_krow(lds + B_QMT, 32 + r32, 32 + 16 * s, hi), n1, psi1);
                yl0 = CS_MFMA(cs_frag_krow(lds + B_BQR, r32, 16 * s, hi), n0, yl0); yl0 = CS_MFMA(cs_frag_krow(lds + B_BQR, r32, 32 + 16 * s, hi), n1, yl0);
                yl1 = CS_MFMA(cs_frag_krow(lds + B_BQR, 32 + r32, 16 * s, hi), n0, yl1); yl1 = CS_MFMA(cs_frag_krow(lds + B_BQR, 32 + r32, 32 + 16 * s, hi), n1, yl1); }
#pragma unroll
            for (int e = 0; e < 16; ++e) { psi0[e] *= GC[crow(e, hi)]; psi1[e] *= GC[32 + crow(e, hi)]; }
            }
            CS_BAR();
            if (local) {
                int ln_ = lane; CS_LAUNDER(ln_);
                const int cu = (((seq - 32) * 8 + h) * 2 + dir) * 32 + c;
                u32x2* dst = (u32x2*)(a.ws + WS_SCR_ACC + ((size_t)cu * 2 + vb) * 8192) + ln_;
#pragma unroll
                for (int g = 0; g < 4; ++g) { u32x2 w;
                    w.x = pk2(psi0[4 * g], psi0[4 * g + 1]); w.y = pk2(psi0[4 * g + 2], psi0[4 * g + 3]); dst[(0 * 4 + g) * 64] = w;
                    w.x = pk2(psi1[4 * g], psi1[4 * g + 1]); w.y = pk2(psi1[4 * g + 2], psi1[4 * g + 3]); dst[(1 * 4 + g) * 64] = w;
                    w.x = pk2(yl0[4 * g], yl0[4 * g + 1]); w.y = pk2(yl0[4 * g + 2], yl0[4 * g + 3]); dst[(2 * 4 + g) * 64] = w;
                    w.x = pk2(yl1[4 * g], yl1[4 * g + 1]); w.y = pk2(yl1[4 * g + 2], yl1[4 * g + 3]); dst[(3 * 4 + g) * 64] = w; }
            } else {
            int ln_ = lane; CS_LAUNDER(ln_); const int r32 = ln_ & 31, hi = ln_ >> 5;
#pragma unroll
            for (int s = 0; s < 2; ++s) { const bf16x8 s0 = s ? sp01 : sp00, s1 = s ? sp11 : sp10;
                yl0 = CS_MFMA(cs_frag_krow(lds + B_GMT, r32, 16 * s, hi), s0, yl0); yl0 = CS_MFMA(cs_frag_krow(lds + B_GMT, r32, 32 + 16 * s, hi), s1, yl0);
                yl1 = CS_MFMA(cs_frag_krow(lds + B_GMT, 32 + r32, 16 * s, hi), s0, yl1); yl1 = CS_MFMA(cs_frag_krow(lds + B_GMT, 32 + r32, 32 + 16 * s, hi), s1, yl1);
                psi0 = CS_MFMA(cs_frag_krow(lds + B_PHT, r32, 16 * s, hi), s0, psi0); psi0 = CS_MFMA(cs_frag_krow(lds + B_PHT, r32, 32 + 16 * s, hi), s1, psi0);
                psi1 = CS_MFMA(cs_frag_krow(lds + B_PHT, 32 + r32, 16 * s, hi), s0, psi1); psi1 = CS_MFMA(cs_frag_krow(lds + B_PHT, 32 + r32, 32 + 16 * s, hi), s1, psi1); }
            sp00 = cs_pack(psi0, 0, 0u); sp01 = cs_pack(psi0, 1, 0u); sp10 = cs_pack(psi1, 0, 0u); sp11 = cs_pack(psi1, 1, 0u);
            if (ctx && c == nch - 1) {
                float* sp = a.out + OUT_STATE + ((((size_t)(seq * 2 + i) * 2 + dir) * 8 + h) * 64 + 32 * vb + r32) * 64;
#pragma unroll
                for (int g = 0; g < 4; ++g) { *(f32x4*)(sp + 8 * g + 4 * hi) = (f32x4){psi0[4 * g], psi0[4 * g + 1], psi0[4 * g + 2], psi0[4 * g + 3]};
                    *(f32x4*)(sp + 32 + 8 * g + 4 * hi) = (f32x4){psi1[4 * g], psi1[4 * g + 1], psi1[4 * g + 2], psi1[4 * g + 3]}; }
            }
            float* yp = Yd + h * 64 + 32 * vb + r32;
#pragma unroll
            for (int e = 0; e < 16; ++e) { const int j0 = c * 64 + crow(e, hi), j1 = j0 + 32;
                yp[(size_t)(dir ? tok_base + T - 1 - j0 : tok_base + j0) * 512] = yl0[e];
                yp[(size_t)(dir ? tok_base + T - 1 - j1 : tok_base + j1) * 512] = yl1[e]; }
            }
        } else if (wave == 3 || wave == 4) {
            CS_BAR();
            {
            int ln_ = lane; CS_LAUNDER(ln_); const int r32 = ln_ & 31, hi = ln_ >> 5;
            f32x16 w0 = cs_zero(), w1 = cs_zero();
#pragma unroll
            for (int s = 0; s < 4; ++s) { const bf16x8 pf = cs_frag(lds + B_PMT, 32 * kb + r32, 16 * s + 8 * hi);
                if (s < 2) w0 = CS_MFMA(cs_frag(lds + B_TT, r32, 16 * s + 8 * hi), pf, w0);
                w1 = CS_MFMA(cs_frag(lds + B_TT, 32 + r32, 16 * s + 8 * hi), pf, w1); }
#pragma unroll
            for (int cb2 = 0; cb2 < 2; ++cb2) {
                f32x16 z = cs_zero(), z2 = cs_zero();
#pragma unroll
                for (int s = 0; s < 2; ++s) { const bf16x8 a0 = cs_pack(w0, s, 0u), a1 = cs_pack(w1, s, 0u);
                    z = CS_MFMA(a0, cs_frag_krow(lds + B_BQR, 32 * cb2 + r32, 16 * s, hi), z); z = CS_MFMA(a1, cs_frag_krow(lds + B_BQR, 32 * cb2 + r32, 32 + 16 * s, hi), z);
                    z2 = CS_MFMA(a0, cs_frag_krow(lds + B_QMT, 32 * cb2 + r32, 16 * s, hi), z2); z2 = CS_MFMA(a1, cs_frag_krow(lds + B_QMT, 32 * cb2 + r32, 32 + 16 * s, hi), z2); }
                const int jrow = 32 * cb2 + r32;
                const float gc = GC[jrow];
#pragma unroll
                for (int g = 0; g < 4; ++g) { const int kc = 32 * kb + 8 * g + 4 * hi;
                    float rr[4]; { const u32x2 rw = *(const LAS u32x2*)(lds + B_RT + (jrow * CP + kc) * 2); rr[0] = bf2f(rw.x & 0xffffu); rr[1] = __uint_as_float(rw.x & 0xffff0000u); rr[2] = bf2f(rw.y & 0xffffu); rr[3] = __uint_as_float(rw.y & 0xffff0000u); }
                    u32x2 wg; wg.x = pk2(rr[0] - z[4 * g], rr[1] - z[4 * g + 1]); wg.y = pk2(rr[2] - z[4 * g + 2], rr[3] - z[4 * g + 3]);
                    *(LAS u32x2*)(lds + B_GMT + (jrow * CP + kc) * 2) = wg;
                    float ph[4];
#pragma unroll
                    for (int e = 0; e < 4; ++e) ph[e] = (((kc + e) == jrow ? 1.f : 0.f) - z2[4 * g + e]) * gc;
                    u32x2 wp; wp.x = pk2(ph[0], ph[1]); wp.y = pk2(ph[2], ph[3]);
                    *(LAS u32x2*)(lds + B_PHT + (jrow * CP + kc) * 2) = wp; }
            }
            }
            CS_BAR();
        } else {
            CS_BAR();
            CS_BAR();
        }
        if (local) {
            int td3 = tid; CS_LAUNDER(td3);
            const int cu = (((seq - 32) * 8 + h) * 2 + dir) * 32 + c;
            u32x4* dst = (u32x4*)(a.ws + WS_SCR_AB + (size_t)cu * 18432);
#pragma unroll
            for (int q = 0; q < 3; ++q) { const int e = td3 + q * NTHR; if (e < 1152) dst[e] = *(const LAS u32x4*)(lds + B_GMT + e * 16); }
        }
    }
    __syncthreads();
}

constexpr int SQ_BUF = 34816;
DI void seq_latent(const P& a, int i, int chain, LAS unsigned char* lds, int tid) {
    const int lane = tid & 63, wave = __builtin_amdgcn_readfirstlane(tid >> 6);
    const int b2 = chain >> 4, h = (chain >> 1) & 7, dir = chain & 1;
    const int r32 = lane & 31, hi = lane >> 5, vb = wave;
    const int tok_base = NCTX + b2 * 2048;
    float* Yd = (float*)(a.ws + WS_Y0) + (size_t)dir * NT * 512;
    const unsigned char* srcAB = a.ws + WS_SCR_AB + (size_t)chain * 32 * 18432;
    const unsigned char* srcACC = a.ws + WS_SCR_ACC + (size_t)chain * 32 * 16384;
#define SQ_ISSUE(c_) do { const int slot_ = (c_) % 3; \
        _Pragma("unroll") for (int q = 0; q < 6; ++q) { int p_ = (wave - 2) + 6 * q; p_ = p_ > 33 ? 33 : p_; \
            const unsigned char* g_ = (p_ < 18) ? srcAB + (size_t)(c_) * 18432 + p_ * 1024 : srcACC + (size_t)(c_) * 16384 + (p_ - 18) * 1024; \
            __builtin_amdgcn_global_load_lds((const unsigned*)(g_ + lane * 16), (LAS unsigned*)(lds + slot_ * SQ_BUF + p_ * 1024), 16, 0, 0); } } while (0)
    bf16x8 sp00, sp01, sp10, sp11;
    if (wave < 2) {
        const float* sp = a.in[I_STATE] + ((((size_t)(b2 * 2 + i) * 2 + dir) * 8 + h) * 64 + 32 * vb + r32) * 64;
        f32x16 st0, st1;
#pragma unroll
        for (int g = 0; g < 4; ++g) { const f32x4 x0 = *(const f32x4*)(sp + 8 * g + 4 * hi), x1 = *(const f32x4*)(sp + 32 + 8 * g + 4 * hi);
#pragma unroll
            for (int e = 0; e < 4; ++e) { st0[4 * g + e] = x0[e]; st1[4 * g + e] = x1[e]; } }
        sp00 = cs_pack(st0, 0, 0u); sp01 = cs_pack(st0, 1, 0u); sp10 = cs_pack(st1, 0, 0u); sp11 = cs_pack(st1, 1, 0u);
        asm volatile("s_waitcnt vmcnt(0)" ::: "memory");
    } else { SQ_ISSUE(0); SQ_ISSUE(1); asm volatile("s_waitcnt vmcnt(6)" ::: "memory"); }
    CS_BAR();
    for (int c = 0; c < 32; ++c) {
        if (wave >= 2) {
            if (c + 2 < 32) { SQ_ISSUE(c + 2); asm volatile("s_waitcnt vmcnt(6)" ::: "memory"); }
            else asm volatile("s_waitcnt vmcnt(0)" ::: "memory");
        } else {
            const LAS unsigned char* B = lds + (c % 3) * SQ_BUF;
            const LAS u32x2* ACC = (const LAS u32x2*)(B + 18432 + vb * 8192) + lane;
            f32x16 psi0, psi1, yl0, yl1;
#pragma unroll
            for (int g = 0; g < 4; ++g) { u32x2 w;
                w = ACC[(0 * 4 + g) * 64]; psi0[4 * g] = bf2f(w.x & 0xffffu); psi0[4 * g + 1] = __uint_as_float(w.x & 0xffff0000u); psi0[4 * g + 2] = bf2f(w.y & 0xffffu); psi0[4 * g + 3] = __uint_as_float(w.y & 0xffff0000u);
                w = ACC[(1 * 4 + g) * 64]; psi1[4 * g] = bf2f(w.x & 0xffffu); psi1[4 * g + 1] = __uint_as_float(w.x & 0xffff0000u); psi1[4 * g + 2] = bf2f(w.y & 0xffffu); psi1[4 * g + 3] = __uint_as_float(w.y & 0xffff0000u);
                w = ACC[(2 * 4 + g) * 64]; yl0[4 * g] = bf2f(w.x & 0xffffu); yl0[4 * g + 1] = __uint_as_float(w.x & 0xffff0000u); yl0[4 * g + 2] = bf2f(w.y & 0xffffu); yl0[4 * g + 3] = __uint_as_float(w.y & 0xffff0000u);
                w = ACC[(3 * 4 + g) * 64]; yl1[4 * g] = bf2f(w.x & 0xffffu); yl1[4 * g + 1] = __uint_as_float(w.x & 0xffff0000u); yl1[4 * g + 2] = bf2f(w.y & 0xffffu); yl1[4 * g + 3] = __uint_as_float(w.y & 0xffff0000u); }
#pragma unroll
            for (int s = 0; s < 2; ++s) { const bf16x8 s0 = s ? sp01 : sp00, s1 = s ? sp11 : sp10;
                yl0 = CS_MFMA(cs_frag_krow(B, r32, 16 * s, hi), s0, yl0); yl0 = CS_MFMA(cs_frag_krow(B, r32, 32 + 16 * s, hi), s1, yl0);
                yl1 = CS_MFMA(cs_frag_krow(B, 32 + r32, 16 * s, hi), s0, yl1); yl1 = CS_MFMA(cs_frag_krow(B, 32 + r32, 32 + 16 * s, hi), s1, yl1);
                psi0 = CS_MFMA(cs_frag_krow(B + CB, r32, 16 * s, hi), s0, psi0); psi0 = CS_MFMA(cs_frag_krow(B + CB, r32, 32 + 16 * s, hi), s1, psi0);
                psi1 = CS_MFMA(cs_frag_krow(B + CB, 32 + r32, 16 * s, hi), s0, psi1); psi1 = CS_MFMA(cs_frag_krow(B + CB, 32 + r32, 32 + 16 * s, hi), s1, psi1); }
            sp00 = cs_pack(psi0, 0, 0u); sp01 = cs_pack(psi0, 1, 0u); sp10 = cs_pack(psi1, 0, 0u); sp11 = cs_pack(psi1, 1, 0u);
            float* yp = Yd + h * 64 + 32 * vb + r32;
#pragma unroll
            for (int e = 0; e < 16; ++e) { const int j0 = c * 64 + crow(e, hi), j1 = j0 + 32;
                yp[(size_t)(dir ? tok_base + 2047 - j0 : tok_base + j0) * 512] = yl0[e];
                yp[(size_t)(dir ? tok_base + 2047 - j1 : tok_base + j1) * 512] = yl1[e]; }
        }
        CS_BAR();
    }
#undef SQ_ISSUE
    __syncthreads();
}
DI void phase_seqlat(const P& a, int i, LAS unsigned char* lds, int tid, int G, int bid) {
    for (int ch = bid; ch < 32; ch += G) seq_latent(a, i, ch, lds, tid);
}

DI int sa_item(int G, int bid, int it) {
    if (G >= 256) {
        if (it < 2) return 1024 + bid + it * G < 1536 ? 1024 + bid + it * G : -2;
        const int j = it - 2;
        if (bid < 64) return j == 0 ? 1536 + bid : -1;
        const int k = bid - 64, n = G - 64; const int nl = (1024 - k + n - 1) / n;
        if (j < nl) return k + j * n;
        const int ua = k + (j - nl) * n; return ua < 128 ? 1600 + ua : -1;
    }
    const int u = bid + it * G; return u < 1728 ? u : -1;
}
DI void phase_scanatt(const P& a, int i, LAS unsigned char* lds, int wave0, int G, int bid) {
    for (int it = 0;; ++it) {
        const int id = sa_item(G, bid, it);
        if (id == -1) break;
        if (id < 0) continue;
        int td_ = wave0 * 64 + lane_id_volatile(); CS_LAUNDER(td_); const int tid = td_, lane = td_ & 63, wave = __builtin_amdgcn_readfirstlane(td_ >> 6);
        if (id < 1536) { const bool lat = id < 1024; const int u = lat ? (id >> 5) : id - 1024;
            scan_chain(a, i, lat ? 32 + (u >> 4) : (u >> 4), (u >> 1) & 7, u & 1, lat ? (id & 31) : 0, lat ? (id & 31) + 1 : 4, lat, lds, tid, lane, wave); }
#ifndef T_NO_ATT
        else { const bool lat = id < 1600; const int u = lat ? id - 1536 : id - 1600;
            attn_unit(a, lat ? 32 + (u >> 5) : (u >> 2), lat ? ((u >> 3) & 3) : (u & 3), lat ? (u & 7) : 0, lds, tid, lane, wave); }
#endif
    }
}

constexpr int NPHASES = 37;
#ifndef DBG_LAST_PHASE
#define DBG_LAST_PHASE (NPHASES - 1)
#endif

__global__ void __launch_bounds__(NTHR, 2) mega_fwd(Args args) {
    extern __shared__ __attribute__((aligned(16))) unsigned char lds_raw[];
    LAS unsigned char* lds = (LAS unsigned char*)lds_raw;
    const int G = gridDim.x, bid = blockIdx.x;
    const int wave0 = __builtin_amdgcn_readfirstlane(threadIdx.x >> 6);
    for (int u = threadIdx.x; u < (LDS_BYTES - LDSCTL_OFF) / 4; u += NTHR) ((LAS unsigned*)(lds + LDSCTL_OFF))[u] = 0u;
    __syncthreads();
    XcdBarrier bar; bar.bar = (unsigned*)(args.ws + WS_CTL) + 4096; bar.x = 0; bar.st = nullptr;
    if (args.use_bar) bar = xcd_barrier_post((unsigned*)(args.ws + WS_CTL) + 4096, (volatile LAS unsigned*)(lds + MISC_OFF) + 8);

    bool redone = false;
    for (int ph = args.ph_lo; ph < args.ph_hi; ++ph) {
        bool redo = false;
        int tid = wave0 * 64 + lane_id_volatile(); asm volatile("" : "+v"(tid));
        const int lane = tid & 63, wave = __builtin_amdgcn_readfirstlane(tid >> 6);
        KIn inp = (KIn)__builtin_amdgcn_kernarg_segment_ptr(); asm volatile("" : "+s"(inp));
        P a; a.in = inp; a.out = (float*)inp[N_IN]; a.ws = (unsigned char*)inp[N_IN + 1];
        unsigned char* ws = a.ws;
        float* Y = a.out + OUT_Y;
        const float* MOD = (const float*)(ws + WS_MOD);
        bf16_t* XN = (bf16_t*)(ws + WS_XN);
        bf16_t* BIG = (bf16_t*)(ws + WS_BIG);
        if (ph == 0) {
#ifndef T_NO_P0
            phase_p0(a, lds, tid, lane, wave, G, bid);
#ifdef REPEAT_P0
            __syncthreads(); phase_p0(a, lds, tid, lane, wave, G, bid);
#endif
#endif
        } else {
            const int p = ph - 1, blk = p / 18, rr = p % 18; const bool even = rr < 12; const int l = 2 * blk + (even ? 0 : 1), sub = even ? rr : rr - 12, i = blk;
            const float* modl = MOD + (size_t)l * 3 * 6144;
            const int kind = even ? (sub < 6 ? sub + 1 : sub == 6 ? 15 : sub) : (sub == 0 ? 12 : sub == 1 ? 13 : sub == 2 ? 14 : sub + 6);
#ifdef REPEAT_MASK
            if (((REPEAT_MASK >> kind) & 1) && !redone) redo = true;
#endif
#ifndef T_NO_MISC
            if (kind == 1) phase_norm(Y, a.in[I_N1G] + l * 1024, modl, 0, 1, XN, nullptr, 0, lane, wave, G, bid);
            else if (kind == 9) phase_norm(Y, a.in[I_N2G] + l * 1024, modl, 3, 4, XN, nullptr, 0, lane, wave, G, bid);
            else if (kind == 12) phase_norm(Y, a.in[I_N1G] + l * 1024, modl, 0, 1, XN, (float*)(ws + WS_RS), 1, lane, wave, G, bid);
            else if (kind == 3) phase_r1(a, i, lane, wave, G, bid);
            else if (kind == 5) phase_m3(a, i, lane, wave, G, bid);
#ifndef T_NO_SA
            else if (kind == 6) phase_scanatt(a, i, lds, wave0, G, bid);
#endif
            else if (kind == 15) phase_seqlat(a, i, lds, tid, G, bid);
            else if (kind == 7) phase_r3(a, i, lane, wave, G, bid);
            else if (kind == 13) phase_p1(a, l, lane, wave, G, bid);
            else
#endif
#ifndef T_NO_GA
            if (kind == 2 || kind == 4) {
                const int njobs = kind == 2 ? 1 : 3;
                for (int j = 0; j < njobs; ++j) {
                    pg8::Gemm g; pg8::EpiBf16 E; E.lora = 0; E.w0 = a.in[I_W0] + i * 1024; E.a0 = a.in[I_A0] + i * 1024;
                    int rot = 0;
                    if (kind == 2) { g = pg8::Gemm{XN, (const bf16_t*)(ws + WS_WINT) + (size_t)i * IN_PAD * 1024, NT, IN_PAD, 1024, 1024, 0}; E.O = BIG; E.ldc = IN_PAD; }
                    else if (j == 0) { g = pg8::Gemm{(const bf16_t*)(ws + WS_L), (const bf16_t*)(ws + WS_WLORAT) + (size_t)i * IN_PAD * 256, NT, IN_PAD, 256, 256, 0}; E.O = BIG; E.ldc = IN_PAD; E.lora = 1; }
                    else if (j == 1) { g = pg8::Gemm{(const bf16_t*)(ws + WS_CQ), (const bf16_t*)(ws + WS_WUQT) + (size_t)i * 768 * 384, NT, 768, 384, 384, 0}; E.O = (bf16_t*)(ws + WS_QRAW); E.ldc = 768; rot = 224; }
                    else { g = pg8::Gemm{(const bf16_t*)(ws + WS_CKV), (const bf16_t*)(ws + WS_WUKVT) + (size_t)i * 1024 * 256, NKV, 1024, 256, 256, 0}; E.O = (bf16_t*)(ws + WS_KVRAW); E.ldc = 1024; rot = 112; }
                    pg8::StaticOrder S; S.init(g.M, g.N, G, (bid + rot) % G);
                    pg8::gemm_phase<pg8::EpiBf16, pg8::StaticOrder, true, true>(lds, g, S, E, tid);
                }
            } else
#endif
#ifndef T_NO_GB
            if (kind == 10) {
                pg8::Gemm g{XN, (const bf16_t*)(ws + WS_W13T) + (size_t)l * 5632 * 1024, NT, 5632, 1024, 1024, 0};
                pg8::EpiSwiglu E{BIG, DFF};
                pg8::StaticOrder S; S.init(g.M, g.N, G, bid);
                pg8::gemm_phase<pg8::EpiSwiglu, pg8::StaticOrder, true, true>(lds, g, S, E, tid);
            } else
#endif
#ifndef T_NO_GC
            if (kind == 8 || kind == 11 || kind == 14) {
                pg8::Gemm g; pg8::EpiResid E; E.Yin = Y; E.Yout = Y; E.ldc = D; E.colscale = nullptr;
                if (kind == 8) { g = pg8::Gemm{XN, (const bf16_t*)(ws + WS_WOUTT) + (size_t)i * 1024 * 1024, NT, 1024, 1024, 1024, 0}; E.gate = modl + 2 * 1024; }
                else if (kind == 11) { g = pg8::Gemm{BIG, (const bf16_t*)(ws + WS_W2T) + (size_t)l * 1024 * DFF, NT, 1024, DFF, DFF, 0}; E.gate = modl + 5 * 1024; }
                else { g = pg8::Gemm{XN, (const bf16_t*)(ws + WS_POOLT) + (size_t)(l >> 1) * 1024 * 256, NT, 1024, 256, 1024, 256}; E.gate = modl + 2 * 1024; E.colscale = a.in[I_POOLS] + (l >> 1) * 1024; }
                pg8::StaticOrder S; S.init(g.M, g.N, G, bid);
                pg8::gemm_phase<pg8::EpiResid, pg8::StaticOrder, true, true>(lds, g, S, E, tid);
            }
#endif
            {}
        }
        if (redo) { redone = true; } else redone = false;
        if (redo || ph + 1 < args.ph_hi) { XcdBarrier b2 = bar; unsigned* bp = (unsigned*)(a.ws + WS_CTL) + 4096; asm volatile("" : "+s"(bp)); b2.bar = bp; xcd_barrier(b2, tid == 0);
#ifdef EXTRA_BAR
            xcd_barrier(b2, tid == 0);
#endif
        }
        if (redo) --ph;
    }
}

#ifdef DBG_MODE
__global__ void dbg_mask(float* out, int total, int base, int period, int lo, int hi, int endb, int base2, int period2, int lo2, int hi2, int endb2, float scale) {
    for (int i = blockIdx.x * blockDim.x + threadIdx.x; i < total; i += gridDim.x * blockDim.x) {
        bool keep = false;
        if (i >= base && i < endb) { const int r = (i - base) % period; keep = (r >= lo && r < hi); }
        if (i >= base2 && i < endb2) { const int r = (i - base2) % period2; keep = keep || (r >= lo2 && r < hi2); }
        out[i] = keep ? scale * out[i] : 0.f;
    }
}
#endif

extern "C" void kernel_launch(void* const* d_in, const int* in_sizes, int n_in, void* d_out, int out_size, void* d_ws, size_t ws_size, hipStream_t stream) {
    static int grid = 0;
    if (grid == 0) {
        if (n_in != N_IN || out_size != OUT_TOTAL || ws_size < WS_END) { fprintf(stderr, "kernel_launch: unexpected shapes: n_in %d out %d ws %zu (need %zu)\n", n_in, out_size, ws_size, (size_t)WS_END); grid = -1; return; }
        int dev = 0, cus = 0;
        if (hipGetDevice(&dev) != hipSuccess || hipDeviceGetAttribute(&cus, hipDeviceAttributeMultiprocessorCount, dev) != hipSuccess) { grid = -1; return; }
        if (hipFuncSetAttribute((const void*)mega_fwd, hipFuncAttributeMaxDynamicSharedMemorySize, LDS_BYTES) != hipSuccess) { fprintf(stderr, "kernel_launch: hipFuncSetAttribute failed\n"); grid = -1; return; }
        (void)hipGetLastError();
        grid = cus;
    }
    if (grid < 0) return;
    Args a{};
    for (int k = 0; k < N_IN; ++k) a.in[k] = (const float*)d_in[k];
    a.out = (float*)d_out; a.ws = (unsigned char*)d_ws;
    (void)hipMemsetAsync((char*)d_ws + WS_CTL, 0, CTL_ZERO_BYTES, stream);
#ifndef ONE_LAUNCH
#define ONE_LAUNCH 0
#endif
    if (ONE_LAUNCH) {
        a.ph_lo = 0; a.ph_hi = DBG_LAST_PHASE + 1; a.use_bar = 1;
        hipLaunchKernelGGL(mega_fwd, dim3(grid), dim3(NTHR), LDS_BYTES, stream, a);
    } else {
        for (int ph = 0; ph <= DBG_LAST_PHASE; ++ph) { a.ph_lo = ph; a.ph_hi = ph + 1; a.use_bar = 0;
            hipLaunchKernelGGL(mega_fwd, dim3(grid), dim3(NTHR), LDS_BYTES, stream, a); }
    }
#ifdef DBG_MODE
    DBG_MASK_CALL
#endif
}
```
